# Optimizing an MI355X kernel written in HIP

```python
import math
import jax, jax.numpy as jnp
from jax import lax
import numpy as np

D_MODEL = 1024
BATCH = 4
SEQ = 4096
DEPTH = 1

MIX_WIDTH = D_MODEL
POOL_WIDTH = D_MODEL // 2
POOL_WINDOWS = (2, 4, 8, 16)
POOL_GROUPS = len(POOL_WINDOWS)
POOL_GROUP_DIM = POOL_WIDTH // POOL_GROUPS

N_HEADS = 8
QK_NOPE_DIM = 64
QK_ROPE_DIM = 32
V_HEAD_DIM = 64
QK_HEAD_DIM = QK_NOPE_DIM + QK_ROPE_DIM
ATTN_WIDTH = N_HEADS * V_HEAD_DIM
Q_LORA_RANK = 384
KV_LORA_RANK = 256
ROPE_THETA = 10000.0
Q_BLOCK = 128

IN_WIDTH = POOL_WIDTH + Q_LORA_RANK + KV_LORA_RANK + QK_ROPE_DIM

FFN_HIDDEN = int(math.ceil(8 * D_MODEL / 3 / 256) * 256)

DEEPNORM_ALPHA = (2.0 * DEPTH) ** 0.25
DEEPNORM_BETA = (8.0 * DEPTH) ** -0.25
LN_EPS = 1e-5
RMS_EPS = 1e-6

kernel_name = "hybrid_pool_mla_deepnorm_encoder"


def layer_norm(x, g, b):
    xf = x.astype(jnp.float32)
    mu = jnp.mean(xf, axis=-1, keepdims=True)
    var = jnp.mean(jnp.square(xf - mu), axis=-1, keepdims=True)
    y = (xf - mu) * lax.rsqrt(var + LN_EPS) * g.astype(jnp.float32) + b.astype(jnp.float32)
    return y.astype(x.dtype)


def rms_norm(x, g):
    xf = x.astype(jnp.float32)
    y = xf * lax.rsqrt(jnp.mean(jnp.square(xf), axis=-1, keepdims=True) + RMS_EPS)
    return (y * g.astype(jnp.float32)).astype(x.dtype)


def rope_tables(positions):
    inv_freq = 1.0 / (ROPE_THETA ** (jnp.arange(0, QK_ROPE_DIM, 2, dtype=jnp.float32) / QK_ROPE_DIM))
    ang = positions.astype(jnp.float32)[..., None] * inv_freq
    return jnp.cos(ang)[:, :, None, :], jnp.sin(ang)[:, :, None, :]


def apply_rope(t, cos, sin):
    tf = t.astype(jnp.float32)
    t1, t2 = jnp.split(tf, 2, axis=-1)
    out = jnp.concatenate([t1 * cos - t2 * sin, t2 * cos + t1 * sin], axis=-1)
    return out.astype(t.dtype)


def centred_mean_minus_self(u, window):
    s = u.shape[1]
    uf = u.astype(jnp.float32)
    cs = jnp.concatenate([jnp.zeros_like(uf[:, :1]), jnp.cumsum(uf, axis=1)], axis=1)
    idx = jnp.arange(s)
    lo = jnp.clip(idx - window // 2, 0, s)
    hi = jnp.clip(idx + window - window // 2, 0, s)
    win_sum = jnp.take(cs, hi, axis=1) - jnp.take(cs, lo, axis=1)
    count = (hi - lo).astype(jnp.float32)[None, :, None]
    return (win_sum / count - uf).astype(u.dtype)


def pool_mixer(u, pool_w, pool_scale):
    outs = []
    for g, w in enumerate(POOL_WINDOWS):
        ug = u[..., g * POOL_GROUP_DIM:(g + 1) * POOL_GROUP_DIM]
        pg = centred_mean_minus_self(ug, w)
        outs.append(jnp.einsum('bsc,cd->bsd', pg, pool_w[g]))
    return jnp.concatenate(outs, axis=-1) * pool_scale


def mla_mixer(cq, ckv, kr, cos, sin, q_norm_g, w_q_up, kv_norm_g, w_k_up, w_v_up):
    b, s, _ = cq.shape
    cq = rms_norm(cq, q_norm_g)
    q = jnp.einsum('bsr,re->bse', cq, w_q_up).reshape(b, s, N_HEADS, QK_HEAD_DIM)
    q = jnp.concatenate([q[..., :QK_NOPE_DIM], apply_rope(q[..., QK_NOPE_DIM:], cos, sin)], axis=-1)
    ckv = rms_norm(ckv, kv_norm_g)
    k_nope = jnp.einsum('bsr,re->bse', ckv, w_k_up).reshape(b, s, N_HEADS, QK_NOPE_DIM)
    v = jnp.einsum('bsr,re->bse', ckv, w_v_up).reshape(b, s, N_HEADS, V_HEAD_DIM)
    k_rope = apply_rope(kr[:, :, None, :], cos, sin)
    k = jnp.concatenate([k_nope, jnp.broadcast_to(k_rope, (b, s, N_HEADS, QK_ROPE_DIM))], axis=-1)
    scale = QK_HEAD_DIM ** -0.5
    n_blocks = s // Q_BLOCK
    q_blocks = q.reshape(b, n_blocks, Q_BLOCK, N_HEADS, QK_HEAD_DIM).transpose(1, 0, 2, 3, 4)

    def attend(qb):
        scores = jnp.einsum('bqhd,bkhd->bhqk', qb, k).astype(jnp.float32) * scale
        p = jax.nn.softmax(scores, axis=-1).astype(v.dtype)
        return jnp.einsum('bhqk,bkhd->bqhd', p, v)

    out = lax.map(attend, q_blocks)
    return out.transpose(1, 0, 2, 3, 4).reshape(b, s, ATTN_WIDTH)


def setup_inputs(seed: int = 0) -> dict:
    key = jax.random.key(seed)
    ks = jax.random.split(key, 20)
    L = DEPTH

    def w(k, shape, fan_in, gain=1.0):
        return jax.random.normal(k, shape, jnp.float32) * (fan_in ** -0.5) * gain

    x = jax.random.normal(ks[0], (BATCH, SEQ, D_MODEL), jnp.float32)
    positions = jnp.broadcast_to(jnp.arange(SEQ, dtype=jnp.int32)[None, :], (BATCH, SEQ))
    return {
        "x": x,
        "positions": positions,
        "w_in": w(ks[1], (L, D_MODEL, IN_WIDTH), D_MODEL),
        "pool_w": w(ks[2], (L, POOL_GROUPS, POOL_GROUP_DIM, POOL_GROUP_DIM), POOL_GROUP_DIM, DEEPNORM_BETA),
        "pool_scale": 1.0 + 0.01 * jax.random.normal(ks[3], (L, POOL_WIDTH), jnp.float32),
        "q_norm_g": 1.0 + 0.01 * jax.random.normal(ks[4], (L, Q_LORA_RANK), jnp.float32),
        "w_q_up": w(ks[5], (L, Q_LORA_RANK, N_HEADS * QK_HEAD_DIM), Q_LORA_RANK),
        "kv_norm_g": 1.0 + 0.01 * jax.random.normal(ks[6], (L, KV_LORA_RANK), jnp.float32),
        "w_k_up": w(ks[7], (L, KV_LORA_RANK, N_HEADS * QK_NOPE_DIM), KV_LORA_RANK),
        "w_v_up": w(ks[8], (L, KV_LORA_RANK, N_HEADS * V_HEAD_DIM), KV_LORA_RANK, DEEPNORM_BETA),
        "w_o": w(ks[9], (L, MIX_WIDTH, D_MODEL), MIX_WIDTH, DEEPNORM_BETA),
        "ln1_g": 1.0 + 0.01 * jax.random.normal(ks[10], (L, D_MODEL), jnp.float32),
        "ln1_b": 0.01 * jax.random.normal(ks[11], (L, D_MODEL), jnp.float32),
        "w_gate": w(ks[12], (L, D_MODEL, FFN_HIDDEN), D_MODEL, DEEPNORM_BETA),
        "w_up": w(ks[13], (L, D_MODEL, FFN_HIDDEN), D_MODEL, DEEPNORM_BETA),
        "w_down": w(ks[14], (L, FFN_HIDDEN, D_MODEL), FFN_HIDDEN, DEEPNORM_BETA),
        "ln2_g": 1.0 + 0.01 * jax.random.normal(ks[15], (L, D_MODEL), jnp.float32),
        "ln2_b": 0.01 * jax.random.normal(ks[16], (L, D_MODEL), jnp.float32),
    }


def reference(x, positions, w_in, pool_w, pool_scale, q_norm_g, w_q_up, kv_norm_g, w_k_up, w_v_up,
              w_o, ln1_g, ln1_b, w_gate, w_up, w_down, ln2_g, ln2_b):
    cos, sin = rope_tables(positions)
    o_q = POOL_WIDTH
    o_kv = o_q + Q_LORA_RANK
    o_kr = o_kv + KV_LORA_RANK
    for l in range(DEPTH):
        h = jnp.einsum('bsd,de->bse', x, w_in[l])
        pool_out = pool_mixer(h[..., :o_q], pool_w[l], pool_scale[l])
        attn_out = mla_mixer(h[..., o_q:o_kv], h[..., o_kv:o_kr], h[..., o_kr:], cos, sin,
                             q_norm_g[l], w_q_up[l], kv_norm_g[l], w_k_up[l], w_v_up[l])
        mix = jnp.einsum('bse,ed->bsd', jnp.concatenate([pool_out, attn_out], axis=-1), w_o[l])
        x = layer_norm(DEEPNORM_ALPHA * x + mix, ln1_g[l], ln1_b[l])
        gate = jnp.einsum('bsd,df->bsf', x, w_gate[l])
        up = jnp.einsum('bsd,df->bsf', x, w_up[l])
        ffn = jnp.einsum('bsf,fd->bsd', jax.nn.silu(gate) * up, w_down[l])
        x = layer_norm(DEEPNORM_ALPHA * x + ffn, ln2_g[l], ln2_b[l])
    return x
```

```cpp
#include <hip/hip_runtime.h>
#include <cstdio>
#include <cstdint>
#include <cmath>

namespace nv {
constexpr int D = 1024, BATCH = 4, SEQ = 4096, M = BATCH * SEQ;
constexpr int POOLW = 512, QR = 384, KVR = 256, ROPE = 32, INW = 1184;
constexpr int NH = 8, NOPE = 64, VD = 64, QKD = 96, FF = 2816;
constexpr float ALPHA = 1.189207115002721f;
constexpr float LN_EPS = 1e-5f, RMS_EPS = 1e-6f;

template <int EPI>
__global__ void __launch_bounds__(256) sgemm(const float* __restrict__ A, int lda, const float* __restrict__ B, int ldb, const float* __restrict__ B2,
                                             float* __restrict__ C, int ldc, int N, int K, const float* __restrict__ aux, int ldaux) {
    __shared__ float As[16][68];
    __shared__ float Bs[16][68];
    __shared__ float Bs2[EPI == 3 ? 16 : 1][68];
    const int tx = threadIdx.x & 15, ty = threadIdx.x >> 4;
    const int m0 = blockIdx.y * 64, n0 = blockIdx.x * 64;
    float acc[4][4] = {}, acc2[4][4] = {};
    for (int k0 = 0; k0 < K; k0 += 16) {
        for (int i = threadIdx.x; i < 64 * 16; i += 256) { const int r = i >> 4, c = i & 15; As[c][r] = A[(size_t)(m0 + r) * lda + k0 + c]; }
        for (int i = threadIdx.x; i < 16 * 64; i += 256) { const int r = i >> 6, c = i & 63; const int n = n0 + c;
            Bs[r][c] = n < N ? B[(size_t)(k0 + r) * ldb + n] : 0.f;
            if (EPI == 3) Bs2[r][c] = n < N ? B2[(size_t)(k0 + r) * ldb + n] : 0.f; }
        __syncthreads();
#pragma unroll
        for (int k = 0; k < 16; ++k) {
            float a[4], b[4], b2[4];
#pragma unroll
            for (int i = 0; i < 4; ++i) { a[i] = As[k][ty * 4 + i]; b[i] = Bs[k][tx * 4 + i]; if (EPI == 3) b2[i] = Bs2[k][tx * 4 + i]; }
#pragma unroll
            for (int i = 0; i < 4; ++i)
#pragma unroll
                for (int j = 0; j < 4; ++j) { acc[i][j] += a[i] * b[j]; if (EPI == 3) acc2[i][j] += a[i] * b2[j]; }
        }
        __syncthreads();
    }
#pragma unroll
    for (int i = 0; i < 4; ++i)
#pragma unroll
        for (int j = 0; j < 4; ++j) {
            const int m = m0 + ty * 4 + i, n = n0 + tx * 4 + j;
            if (n >= N) continue;
            float v = acc[i][j];
            if (EPI == 1) v *= aux[n];
            if (EPI == 2) v += ALPHA * aux[(size_t)m * ldaux + n];
            if (EPI == 3) { const float g = v; v = g / (1.f + expf(-g)) * acc2[i][j]; }
            C[(size_t)m * ldc + n] = v;
        }
}

__global__ void pool_window(const float* __restrict__ H, float* __restrict__ PG) {
    const int idx = blockIdx.x * blockDim.x + threadIdx.x;
    if (idx >= M * POOLW) return;
    const int m = idx / POOLW, c = idx % POOLW, g = c / 128, w = 2 << g;
    const int s = m % SEQ, b0 = m - s;
    int lo = s - w / 2; if (lo < 0) lo = 0;
    int hi = s + w - w / 2; if (hi > SEQ) hi = SEQ;
    float sum = 0.f;
    for (int j = lo; j < hi; ++j) sum += H[(size_t)(b0 + j) * INW + c];
    PG[(size_t)m * POOLW + c] = sum / (float)(hi - lo) - H[(size_t)m * INW + c];
}

__device__ __forceinline__ float block_sum(float v, float* red) {
#pragma unroll
    for (int o = 32; o > 0; o >>= 1) v += __shfl_xor(v, o);
    const int w = threadIdx.x >> 6;
    __syncthreads();
    if ((threadIdx.x & 63) == 0) red[w] = v;
    __syncthreads();
    float t = 0.f;
    for (int i = 0; i < (int)(blockDim.x >> 6); ++i) t += red[i];
    return t;
}

struct RopeTab { double inv_freq[16]; };
__global__ void __launch_bounds__(256) norm_rope(float* __restrict__ H, const int* __restrict__ pos, const float* __restrict__ qg, const float* __restrict__ kvg,
                                                 float* __restrict__ cs, RopeTab tab) {
    __shared__ float red[4];
    const int m = blockIdx.x; float* h = H + (size_t)m * INW;
    float s = 0.f;
    for (int i = threadIdx.x; i < QR; i += 256) { const float v = h[POOLW + i]; s += v * v; }
    const float rq = rsqrtf(block_sum(s, red) / QR + RMS_EPS);
    s = 0.f;
    for (int i = threadIdx.x; i < KVR; i += 256) { const float v = h[POOLW + QR + i]; s += v * v; }
    const float rk = rsqrtf(block_sum(s, red) / KVR + RMS_EPS);
    for (int i = threadIdx.x; i < QR; i += 256) h[POOLW + i] = h[POOLW + i] * rq * qg[i];
    for (int i = threadIdx.x; i < KVR; i += 256) h[POOLW + QR + i] = h[POOLW + QR + i] * rk * kvg[i];
    if (threadIdx.x < 16) {
        const int i = threadIdx.x;
        const double t = (double)pos[m] * tab.inv_freq[i] * 0.15915494309189535;
        const float rev = (float)(t - rint(t));
        const float c = __builtin_amdgcn_cosf(rev), sn = __builtin_amdgcn_sinf(rev);
        cs[(size_t)m * 32 + i] = c; cs[(size_t)m * 32 + 16 + i] = sn;
        const float t1 = h[POOLW + QR + KVR + i], t2 = h[POOLW + QR + KVR + 16 + i];
        h[POOLW + QR + KVR + i] = t1 * c - t2 * sn; h[POOLW + QR + KVR + 16 + i] = t2 * c + t1 * sn;
    }
}

__global__ void q_rope(float* __restrict__ Q, const float* __restrict__ cs) {
    const int idx = blockIdx.x * blockDim.x + threadIdx.x;
    if (idx >= M * NH * 16) return;
    const int m = idx / (NH * 16), r = idx % (NH * 16), h = r / 16, i = r % 16;
    float* q = Q + (size_t)m * (NH * QKD) + h * QKD + NOPE;
    const float c = cs[(size_t)m * 32 + i], sn = cs[(size_t)m * 32 + 16 + i];
    const float t1 = q[i], t2 = q[16 + i];
    q[i] = t1 * c - t2 * sn; q[16 + i] = t2 * c + t1 * sn;
}

__global__ void __launch_bounds__(64) attn_naive(const float* __restrict__ Q, const float* __restrict__ Kn, const float* __restrict__ H, const float* __restrict__ V, float* __restrict__ CAT) {
    const int qi = blockIdx.x * 64 + threadIdx.x, h = blockIdx.y, b = blockIdx.z;
    const int m = b * SEQ + qi;
    float q[QKD], o[VD];
    const float scale = 0.10206207261596577f;
#pragma unroll
    for (int d = 0; d < QKD; ++d) q[d] = Q[(size_t)m * (NH * QKD) + h * QKD + d] * scale;
#pragma unroll
    for (int d = 0; d < VD; ++d) o[d] = 0.f;
    float mx = -INFINITY, l = 0.f;
    for (int j = 0; j < SEQ; ++j) {
        const size_t mj = (size_t)b * SEQ + j;
        const float* kn = Kn + mj * 512 + h * 64; const float* kr = H + mj * INW + POOLW + QR + KVR; const float* v = V + mj * 512 + h * 64;
        float s = 0.f;
#pragma unroll
        for (int d = 0; d < NOPE; ++d) s += q[d] * kn[d];
#pragma unroll
        for (int d = 0; d < ROPE; ++d) s += q[NOPE + d] * kr[d];
        if (s > mx) { const float sc = __expf(mx - s); l *= sc;
#pragma unroll
            for (int d = 0; d < VD; ++d) o[d] *= sc;
            mx = s; }
        const float p = __expf(s - mx); l += p;
#pragma unroll
        for (int d = 0; d < VD; ++d) o[d] += p * v[d];
    }
    const float inv = 1.f / l;
#pragma unroll
    for (int d = 0; d < VD; ++d) CAT[(size_t)m * 1024 + 512 + h * 64 + d] = o[d] * inv;
}

__global__ void __launch_bounds__(256) ln_rows(const float* __restrict__ Y, float* __restrict__ O, const float* __restrict__ g, const float* __restrict__ bta) {
    __shared__ float red[4];
    const int m = blockIdx.x; const float* y = Y + (size_t)m * D; float v[4]; float s = 0.f;
#pragma unroll
    for (int i = 0; i < 4; ++i) { v[i] = y[threadIdx.x + 256 * i]; s += v[i]; }
    const float mu = block_sum(s, red) / D; float s2 = 0.f;
#pragma unroll
    for (int i = 0; i < 4; ++i) { v[i] -= mu; s2 += v[i] * v[i]; }
    const float rstd = rsqrtf(block_sum(s2, red) / D + LN_EPS);
#pragma unroll
    for (int i = 0; i < 4; ++i) { const int c = threadIdx.x + 256 * i; O[(size_t)m * D + c] = v[i] * rstd * g[c] + bta[c]; }
}
}

extern "C" void kernel_launch(void* const* d_in, const int* in_sizes, int n_in, void* d_out, int out_size, void* d_ws, size_t ws_size, hipStream_t stream) {
    using namespace nv;
    const float* x = (const float*)d_in[0]; const int* pos = (const int*)d_in[1];
    const float* w_in = (const float*)d_in[2]; const float* pool_w = (const float*)d_in[3]; const float* pool_scale = (const float*)d_in[4];
    const float* qg = (const float*)d_in[5]; const float* w_q_up = (const float*)d_in[6]; const float* kvg = (const float*)d_in[7];
    const float* w_k_up = (const float*)d_in[8]; const float* w_v_up = (const float*)d_in[9]; const float* w_o = (const float*)d_in[10];
    const float* ln1_g = (const float*)d_in[11]; const float* ln1_b = (const float*)d_in[12];
    const float* w_gate = (const float*)d_in[13]; const float* w_up = (const float*)d_in[14]; const float* w_down = (const float*)d_in[15];
    const float* ln2_g = (const float*)d_in[16]; const float* ln2_b = (const float*)d_in[17];
    float* out = (float*)d_out; char* ws = (char*)d_ws;
    const size_t MB = 1000000;
    float* H = (float*)(ws + 0);
    float* PG = (float*)(ws + 78 * MB);
    float* CAT = (float*)(ws + 112 * MB);
    float* Q = (float*)(ws + 180 * MB);
    float* Kn = (float*)(ws + 231 * MB);
    float* CS = (float*)(ws + 265 * MB);
    float* V = PG;
    float* X1 = H;
    float* HH = (float*)(ws + 68 * MB);
    RopeTab tab;
    for (int i = 0; i < 16; ++i) tab.inv_freq[i] = 1.0 / pow(10000.0, (double)(2 * i) / 32.0);
    sgemm<0><<<dim3((INW + 63) / 64, M / 64), 256, 0, stream>>>(x, D, w_in, INW, nullptr, H, INW, INW, D, nullptr, 0);
    pool_window<<<(M * POOLW + 255) / 256, 256, 0, stream>>>(H, PG);
    for (int g = 0; g < 4; ++g)
        sgemm<1><<<dim3(2, M / 64), 256, 0, stream>>>(PG + g * 128, POOLW, pool_w + g * 128 * 128, 128, nullptr, CAT + g * 128, 1024, 128, 128, pool_scale + g * 128, 0);
    norm_rope<<<M, 256, 0, stream>>>(H, pos, qg, kvg, CS, tab);
    sgemm<0><<<dim3(768 / 64, M / 64), 256, 0, stream>>>(H + POOLW, INW, w_q_up, 768, nullptr, Q, 768, 768, QR, nullptr, 0);
    q_rope<<<(M * NH * 16 + 255) / 256, 256, 0, stream>>>(Q, CS);
    sgemm<0><<<dim3(512 / 64, M / 64), 256, 0, stream>>>(H + POOLW + QR, INW, w_k_up, 512, nullptr, Kn, 512, 512, KVR, nullptr, 0);
    sgemm<0><<<dim3(512 / 64, M / 64), 256, 0, stream>>>(H + POOLW + QR, INW, w_v_up, 512, nullptr, V, 512, 512, KVR, nullptr, 0);
    attn_naive<<<dim3(SEQ / 64, NH, BATCH), 64, 0, stream>>>(Q, Kn, H, V, CAT);
    sgemm<2><<<dim3(D / 64, M / 64), 256, 0, stream>>>(CAT, 1024, w_o, D, nullptr, X1, D, D, 1024, x, D);
    ln_rows<<<M, 256, 0, stream>>>(X1, X1, ln1_g, ln1_b);
    sgemm<3><<<dim3(FF / 64, M / 64), 256, 0, stream>>>(X1, D, w_gate, FF, w_up, HH, FF, FF, D, nullptr, 0);
    sgemm<2><<<dim3(D / 64, M / 64), 256, 0, stream>>>(HH, FF, w_down, D, nullptr, out, D, D, FF, X1, D);
    ln_rows<<<M, 256, 0, stream>>>(out, out, ln2_g, ln2_b);
}
```

```cpp
#include <hip/hip_runtime.h>
#include <hip/hip_cooperative_groups.h>
#include <cstdio>
#include <cstdint>
#include <cmath>
namespace cg = cooperative_groups;
__device__ __forceinline__ int lane_id_v() { int l; asm volatile("v_mbcnt_lo_u32_b32 %0, -1, 0\n\tv_mbcnt_hi_u32_b32 %0, -1, %0" : "=v"(l)); return l; }
namespace pg8 {
#define PG8_LAS __attribute__((address_space(3)))
typedef unsigned short bf16_t;
typedef short bf16x8 __attribute__((ext_vector_type(8)));
typedef float f32x4 __attribute__((ext_vector_type(4)));
typedef unsigned u32x4 __attribute__((ext_vector_type(4)));
constexpr int BM = 256, BK = 64, HALF = 128, HTB = HALF * BK * 2  , STAGE_BYTES = 8 * HTB, NXCD = 8, WGM = 8;

__host__ __device__ __forceinline__ int lds_byte(int r, int c) { const int st = (r >> 4) * 2 + (c >> 5), rr = r & 15, cc = c & 31, ob = rr * 64 + cc * 2; return st * 1024 + (ob ^ (((ob >> 9) & 1) << 5)); }
__host__ __device__ __forceinline__ void stage_rc(int b, int& R, int& C) { const int st = b / 1024, sb = b % 1024, swz = sb ^ (((sb >> 9) & 1) << 5); R = (st >> 1) * 16 + swz / 64; C = (st & 1) * 32 + (swz % 64) / 2; }
__host__ __device__ __forceinline__ int perm32(int rho) { const int n = rho >> 4, i = rho & 15; return 8 * (i >> 2) + 4 * n + (i & 3); }

struct Unit { int pm, pn; };
struct Gemm { const bf16_t* A; const bf16_t* Bt; int M, N, K; };

struct StaticOrder {
    int nM, nN, nwg, G, c;
    __host__ __device__ void init(int M, int N, int G_, int c_) { nM = M / BM; nN = N / BM; nwg = nM * nN; G = G_; c = c_; }
    __host__ __device__ bool next(int i, Unit& u) const {
        const long L = (long)i * G + c; if (L >= nwg) return false;
        int wgid = (int)L; { const int q = nwg / NXCD, r = nwg % NXCD, xcd = wgid % NXCD, off = wgid / NXCD; wgid = (xcd < r ? xcd * (q + 1) : r * (q + 1) + (xcd - r) * q) + off; }
        const int nig = WGM * nN, gid = wgid / nig, fm = gid * WGM, gsz = (nM - fm) < WGM ? (nM - fm) : WGM;
        u.pm = fm + ((wgid % nig) % gsz); u.pn = (wgid % nig) / gsz; return true;
    }
    __device__ __forceinline__ void a_ready(const Unit&) const {}
    __device__ __forceinline__ void done(const Unit&) const {}
};

__device__ __forceinline__ unsigned cvt_pk_bf16(float lo, float hi) { unsigned r; asm volatile("v_cvt_pk_bf16_f32 %0, %1, %2" : "=v"(r) : "v"(lo), "v"(hi)); return r; }
template <class Epi, class Sched, bool ALIGN_EPI = false, bool SP2 = false>
__device__ __forceinline__ void gemm_phase(PG8_LAS unsigned char* lds, const Gemm g, const Sched& S, const Epi& E, int wave_in) {
    const int tid_l = wave_in * 64 + lane_id_v();
    const int tid = tid_l, wid = __builtin_amdgcn_readfirstlane(tid >> 6), lane = tid & 63, wr = wid >> 2, wc = wid & 3, fr = lane & 15, fq = lane >> 4;
    const int K = g.K, nt = K / BK;
    unsigned voffA[2], voffB[2];
#pragma unroll
    for (int i = 0; i < 2; ++i) { int R, C; stage_rc(tid * 16 + i * 8192, R, C); const int Rb = Epi::PERM ? ((R & ~31) + perm32(R & 31)) : R;
        voffA[i] = (unsigned)(R * K + C) * 2u; voffB[i] = (unsigned)(Rb * K + C) * 2u; }
    const size_t kstep = (size_t)(BK * 2);
    const size_t hstep = (size_t)HALF * K * 2;
    const size_t tstep = 2 * hstep;
    const unsigned ldsw = (unsigned)wid * 1024u;
    const int aoff = lds_byte(wr * 64 + fr, fq * 8), boff = lds_byte(wc * 32 + fr, fq * 8);
#define PG8_SA(b, h) (((b) * 2 + (h)) * HTB)
#define PG8_SB(b, h) ((4 + (b) * 2 + (h)) * HTB)
#define PG8_STAGE(bufoff, gbase, voff) do { _Pragma("unroll") for (int _i = 0; _i < 2; ++_i) \
        __builtin_amdgcn_global_load_lds((const unsigned*)((const char*)(gbase) + (voff)[_i]), (PG8_LAS unsigned*)(lds + (bufoff) + ldsw + _i * 8192), 16, 0, 0); } while (0)
#define PG8_LDA(dst, b, h) do { _Pragma("unroll") for (int m = 0; m < 4; ++m) _Pragma("unroll") for (int k = 0; k < 2; ++k) dst[m][k] = *(const PG8_LAS bf16x8*)(lds + PG8_SA(b, h) + aoff + m * 2048 + k * 1024); } while (0)
#define PG8_LDB(dst, b, h) do { _Pragma("unroll") for (int n = 0; n < 2; ++n) _Pragma("unroll") for (int k = 0; k < 2; ++k) dst[n][k] = *(const PG8_LAS bf16x8*)(lds + PG8_SB(b, h) + boff + n * 2048 + k * 1024); } while (0)
#define PG8_MMA(ai, bj, At, Bt) do { __builtin_amdgcn_s_setprio(1); _Pragma("unroll") for (int m = 0; m < 4; ++m) _Pragma("unroll") for (int n = 0; n < 2; ++n) _Pragma("unroll") for (int k = 0; k < 2; ++k) \
        acc[ai][bj][m][n] = __builtin_amdgcn_mfma_f32_16x16x32_bf16(Bt[n][k], At[m][k], acc[ai][bj][m][n], 0, 0, 0); __builtin_amdgcn_s_setprio(0); } while (0)
#define PG8_WAIT_V(n) asm volatile("s_waitcnt vmcnt(" #n ")" ::: "memory")
#define PG8_WAIT_L(n) asm volatile("s_waitcnt lgkmcnt(" #n ")" ::: "memory")
#define PG8_BAR __builtin_amdgcn_s_barrier()
#define PG8_SCHED __builtin_amdgcn_sched_barrier(0)
    Unit cur, nxt; int ui = 0;
    if (!S.next(0, cur)) return;
    f32x4 acc[2][2][4][2];
#pragma unroll
    for (int a = 0; a < 2; ++a)
#pragma unroll
        for (int b = 0; b < 2; ++b)
#pragma unroll
            for (int m = 0; m < 4; ++m)
#pragma unroll
                for (int n = 0; n < 2; ++n) acc[a][b][m][n] = (f32x4){0.f, 0.f, 0.f, 0.f};
    bf16x8 At[4][2], B0[2][2], B1[2][2];
    const char* cA = (const char*)g.A + (size_t)cur.pm * tstep; const char* cB = (const char*)g.Bt + (size_t)cur.pn * tstep;
    S.a_ready(cur);
    if constexpr (SP2) {
        PG8_STAGE(PG8_SB(0, 0), cB, voffB); PG8_STAGE(PG8_SB(0, 1), cB + hstep, voffB); PG8_STAGE(PG8_SA(0, 0), cA, voffA); PG8_STAGE(PG8_SA(0, 1), cA + hstep, voffA);
        if (wr == 1) PG8_BAR;
        PG8_WAIT_V(2); PG8_BAR;
        PG8_STAGE(PG8_SB(1, 0), cB + kstep, voffB); PG8_STAGE(PG8_SA(1, 0), cA + kstep, voffA); PG8_STAGE(PG8_SB(1, 1), cB + hstep + kstep, voffB);
        PG8_WAIT_V(6); PG8_BAR;
    } else {
        PG8_STAGE(PG8_SB(0, 0), cB, voffB); PG8_STAGE(PG8_SA(0, 0), cA, voffA); PG8_STAGE(PG8_SB(0, 1), cB + hstep, voffB); PG8_STAGE(PG8_SA(0, 1), cA + hstep, voffA);
        if (wr == 1) PG8_BAR;
        PG8_WAIT_V(4); PG8_BAR;
        PG8_STAGE(PG8_SB(1, 0), cB + kstep, voffB); PG8_STAGE(PG8_SA(1, 0), cA + kstep, voffA); PG8_STAGE(PG8_SB(1, 1), cB + hstep + kstep, voffB);
        PG8_WAIT_V(6); PG8_BAR;
    }
    for (;;) {
        const bool has_next = S.next(ui + 1, nxt);
        const char* nA = has_next ? (const char*)g.A + (size_t)nxt.pm * tstep : cA; const char* nB = has_next ? (const char*)g.Bt + (size_t)nxt.pn * tstep : cB;
        for (int t = 0; t < nt; t += 2) {
            const bool last = (t == nt - 2);
            const char* a1 = cA + (size_t)(t + 1) * kstep;
            const char* a2 = last ? nA : cA + (size_t)(t + 2) * kstep; const char* b2 = last ? nB : cB + (size_t)(t + 2) * kstep;
            const char* a3 = a2 + kstep; const char* b3 = b2 + kstep;
            if (last && has_next) S.a_ready(nxt);
            if constexpr (SP2) {
            PG8_LDB(B0, 0, 0); PG8_LDB(B1, 0, 1); PG8_SCHED; PG8_LDA(At, 0, 0); PG8_STAGE(PG8_SA(1, 1), a1 + hstep, voffA);
            PG8_WAIT_V(8); PG8_WAIT_L(0); PG8_BAR; PG8_MMA(0, 0, At, B0); PG8_MMA(0, 1, At, B1); PG8_BAR; PG8_SCHED;
            PG8_LDA(At, 0, 1); PG8_STAGE(PG8_SB(0, 0), b2, voffB); PG8_STAGE(PG8_SB(0, 1), b2 + hstep, voffB); PG8_STAGE(PG8_SA(0, 0), a2, voffA);
            PG8_WAIT_V(8); PG8_WAIT_L(0); PG8_BAR; PG8_MMA(1, 0, At, B0); PG8_MMA(1, 1, At, B1); PG8_BAR; PG8_SCHED;
            PG8_LDB(B0, 1, 0); PG8_LDB(B1, 1, 1); PG8_SCHED; PG8_LDA(At, 1, 0); PG8_STAGE(PG8_SA(0, 1), a2 + hstep, voffA);
            PG8_WAIT_V(8); PG8_WAIT_L(0); PG8_BAR; PG8_MMA(0, 0, At, B0); PG8_MMA(0, 1, At, B1); PG8_BAR; PG8_SCHED;
            PG8_LDA(At, 1, 1); PG8_STAGE(PG8_SB(1, 0), b3, voffB); PG8_STAGE(PG8_SB(1, 1), b3 + hstep, voffB); PG8_STAGE(PG8_SA(1, 0), a3, voffA);
            PG8_WAIT_V(8); PG8_WAIT_L(0); PG8_BAR; PG8_MMA(1, 0, At, B0); PG8_MMA(1, 1, At, B1); PG8_BAR; PG8_SCHED;
            } else {
            PG8_LDB(B0, 0, 0); PG8_SCHED; PG8_LDA(At, 0, 0); PG8_STAGE(PG8_SA(1, 1), a1 + hstep, voffA);
            PG8_WAIT_L(8); PG8_BAR; PG8_WAIT_L(0); PG8_MMA(0, 0, At, B0); PG8_BAR; PG8_SCHED;
            PG8_LDB(B1, 0, 1); PG8_STAGE(PG8_SB(0, 0), b2, voffB);
            PG8_BAR; PG8_WAIT_L(0); PG8_MMA(0, 1, At, B1); PG8_BAR;
            PG8_LDA(At, 0, 1); PG8_STAGE(PG8_SA(0, 0), a2, voffA);
            PG8_BAR; PG8_WAIT_L(0); PG8_MMA(1, 0, At, B0); PG8_BAR; PG8_SCHED;
            PG8_STAGE(PG8_SB(0, 1), b2 + hstep, voffB);
            PG8_WAIT_V(6); PG8_BAR; PG8_MMA(1, 1, At, B1); PG8_BAR;
            PG8_LDB(B0, 1, 0); PG8_SCHED; PG8_LDA(At, 1, 0); PG8_STAGE(PG8_SA(0, 1), a2 + hstep, voffA);
            PG8_WAIT_L(8); PG8_BAR; PG8_WAIT_L(0); PG8_MMA(0, 0, At, B0); PG8_BAR; PG8_SCHED;
            PG8_LDB(B1, 1, 1); PG8_STAGE(PG8_SB(1, 0), b3, voffB);
            PG8_BAR; PG8_WAIT_L(0); PG8_MMA(0, 1, At, B1); PG8_BAR;
            PG8_LDA(At, 1, 1); PG8_STAGE(PG8_SA(1, 0), a3, voffA);
            PG8_BAR; PG8_WAIT_L(0); PG8_MMA(1, 0, At, B0); PG8_BAR; PG8_SCHED;
            PG8_STAGE(PG8_SB(1, 1), b3 + hstep, voffB);
            PG8_WAIT_V(6); PG8_BAR; PG8_MMA(1, 1, At, B1); PG8_BAR;
            }
        }
        if constexpr (ALIGN_EPI) { if (wr == 0) PG8_BAR; }
        if constexpr (!Epi::AFTER_DRAIN) { E(acc, cur, wr, wc, fr, fq); S.done(cur); }
        if (!has_next) break;
#pragma unroll
        for (int a = 0; a < 2; ++a)
#pragma unroll
            for (int b = 0; b < 2; ++b)
#pragma unroll
                for (int m = 0; m < 4; ++m)
#pragma unroll
                    for (int n = 0; n < 2; ++n) acc[a][b][m][n] = (f32x4){0.f, 0.f, 0.f, 0.f};
        cur = nxt; cA = nA; cB = nB; ++ui;
        if constexpr (ALIGN_EPI) { if (wr == 1) PG8_BAR; }
    }
    PG8_WAIT_V(0);
    if constexpr (!ALIGN_EPI) { if (wr == 0) PG8_BAR; }
    PG8_BAR;
    if constexpr (Epi::AFTER_DRAIN) { E.fused(acc, cur, wr, wc, fr, fq, lds, wid, lane); S.done(cur); }
#undef PG8_SA
#undef PG8_SB
#undef PG8_STAGE
#undef PG8_LDA
#undef PG8_LDB
#undef PG8_MMA
#undef PG8_WAIT_V
#undef PG8_WAIT_L
#undef PG8_BAR
#undef PG8_SCHED
}
}

#ifndef MK_PER_PHASE
#define MK_PER_PHASE 0
#endif
constexpr int D = 1024, BATCH = 4, SEQ = 4096, M = BATCH * SEQ;
constexpr int POOLW = 512, QR = 384, KVR = 256, INW = 1184, INWP = 1280;
constexpr int NH = 8, QKD = 96, VD = 64, FF = 2816;
constexpr float ALPHA = 1.189207115002721f, LN_EPS = 1e-5f, RMS_EPS = 1e-6f;
constexpr float SCQ = 0.14724444602590306f;
constexpr size_t MiB = 1u << 20;
constexpr size_t WS_WIN = 1 * MiB, WS_WPOOL = 7 * MiB / 2, WS_WQ = 4 * MiB, WS_WKV = 5 * MiB, WS_WO = 6 * MiB, WS_WGU = 8 * MiB, WS_WD = 19 * MiB;
constexpr size_t WS_XB = 25 * MiB, WS_U = 57 * MiB, WS_CQ = 73 * MiB, WS_CKV = 85 * MiB, WS_KR = 93 * MiB, WS_CS = 94 * MiB, WS_RSTD = 96 * MiB, WS_PG = 97 * MiB;
constexpr size_t WS_CAT = 113 * MiB, WS_Q = 145 * MiB, WS_K = 169 * MiB, WS_VT = 193 * MiB;
constexpr size_t WS_Y1 = 25 * MiB;
constexpr size_t WS_X1B = 209 * MiB;
constexpr size_t WS_HB = 113 * MiB;
constexpr size_t WS_END = 256 * MiB;
static_assert(WS_WD + (size_t)D * FF * 2 <= WS_XB && WS_HB + (size_t)M * FF * 2 <= WS_X1B && WS_X1B + (size_t)M * D * 2 <= WS_END && WS_Y1 + (size_t)M * D * 4 <= WS_KR, "ws map");
constexpr int LDS_BYTES = 147456;
constexpr int NWAVES = 8;

#define LAS __attribute__((address_space(3)))
typedef unsigned short bf16;
typedef unsigned u32x4 __attribute__((ext_vector_type(4)));
typedef unsigned u32x2 __attribute__((ext_vector_type(2)));
typedef float f32x4 __attribute__((ext_vector_type(4)));
typedef float f32x16 __attribute__((ext_vector_type(16)));
typedef short bf16x8 __attribute__((ext_vector_type(8)));

__device__ __forceinline__ unsigned pk2(float lo, float hi) { return pg8::cvt_pk_bf16(lo, hi); }
__device__ __forceinline__ u32x4 pack8(f32x4 a, f32x4 b) { u32x4 w; w.x = pk2(a[0], a[1]); w.y = pk2(a[2], a[3]); w.z = pk2(b[0], b[1]); w.w = pk2(b[2], b[3]); return w; }
__device__ __forceinline__ float bflo(unsigned w) { return __uint_as_float(w << 16); }
__device__ __forceinline__ float bfhi(unsigned w) { return __uint_as_float(w & 0xffff0000u); }
__device__ __forceinline__ float wave_sum(float v) {
#pragma unroll
    for (int o = 1; o < 64; o <<= 1) v += __shfl_xor(v, o);
    return v;
}

#define XB_TMO      128
#define XB_XCNT(j)  (256  + 64 * (j))
#define XB_XSUB(j)  (1280 + 64 * (j))
#define XB_XGEN(j)  (2304 + 64 * (j))
#define XB_TOP      3328
#define XB_TOPGEN   3392
#define XCD_BAR_WORDS 3456
#define XB_SPIN_CAP (1u << 18)

__device__ __forceinline__ unsigned xb_ld(unsigned* p)              { return __hip_atomic_load(p, __ATOMIC_RELAXED, __HIP_MEMORY_SCOPE_AGENT); }
__device__ __forceinline__ unsigned xb_add(unsigned* p, unsigned v) { return __hip_atomic_fetch_add(p, v, __ATOMIC_RELAXED, __HIP_MEMORY_SCOPE_AGENT); }
__device__ __forceinline__ unsigned xb_xcc_id() { return (unsigned)__builtin_amdgcn_s_getreg((3 << 11) | 20) & 0xFu; }
#define XB_SPIN(cond, bar) do { unsigned _sp = 0; while (cond) { __builtin_amdgcn_s_sleep(1); \
    if ((++_sp & 255u) == 0u) { if (xb_ld(&(bar)[XB_TMO])) break; if (_sp > XB_SPIN_CAP) { atomicAdd(&(bar)[XB_TMO], 1u); break; } } } } while (0)

struct XcdBarrier {
    unsigned* bar; unsigned x;
    volatile LAS unsigned* st;
};

__device__ __forceinline__ XcdBarrier xcd_barrier_post(unsigned* bar, volatile LAS unsigned* st, bool t0) {
    XcdBarrier b; b.bar = bar; b.x = xb_xcc_id(); b.st = st;
    if (t0) (void)xb_add(&bar[XB_XCNT(b.x)], 1u);
    return b;
}
__device__ __forceinline__ void xcd_barrier_complete(unsigned* bar, unsigned x, unsigned& nloc, unsigned& nx) {
    const unsigned G = gridDim.x * gridDim.y * gridDim.z;
    unsigned sum, cnt, mine, sp = 0u;
    for (;;) {
        sum = 0u; cnt = 0u; mine = 0u;
#pragma unroll
        for (unsigned j = 0; j < 16; ++j) { const unsigned c = xb_ld(&bar[XB_XCNT(j)]); sum += c; cnt += (c > 0u) ? 1u : 0u; mine = (j == x) ? c : mine; }
        if (sum == G) break;
        __builtin_amdgcn_s_sleep(1);
        if ((++sp & 255u) == 0u) { if (xb_ld(&bar[XB_TMO])) break; if (sp > XB_SPIN_CAP) { atomicAdd(&bar[XB_TMO], 1u); break; } }
    }
    nloc = mine > 0u ? mine : 1u; nx = cnt > 0u ? cnt : 1u;
}

__device__ __forceinline__ void xcd_barrier(const XcdBarrier& b, bool t0) {
    asm volatile("s_waitcnt vmcnt(0)" ::: "memory");
    __syncthreads();
    if (t0) {
        unsigned* bar = b.bar;
        __builtin_amdgcn_s_waitcnt(0);
        unsigned nloc = b.st[0], nx = b.st[1];
        if (nloc == 0u) { xcd_barrier_complete(bar, b.x, nloc, nx); b.st[0] = nloc; b.st[1] = nx; }
        const unsigned old = xb_add(&bar[XB_XSUB(b.x)], 1u);
        const unsigned gen = old / nloc;
        if (old + 1u == (gen + 1u) * nloc) {
            __builtin_amdgcn_fence(__ATOMIC_RELEASE, "agent");
            asm volatile("s_waitcnt vmcnt(0)" ::: "memory");
            const unsigned og = xb_add(&bar[XB_TOP], 1u);
            const unsigned tg = og / nx;
            if (og + 1u == (tg + 1u) * nx) xb_add(&bar[XB_TOPGEN], 1u);
            else XB_SPIN(xb_ld(&bar[XB_TOPGEN]) == tg, bar);
            __builtin_amdgcn_fence(__ATOMIC_ACQUIRE, "agent");
            xb_add(&bar[XB_XGEN(b.x)], 1u);
            asm volatile("s_waitcnt vmcnt(0)" ::: "memory");
        } else {
            XB_SPIN(xb_ld(&bar[XB_XGEN(b.x)]) == gen, bar);
            __builtin_amdgcn_fence(__ATOMIC_ACQUIRE, "agent");
            asm volatile("s_waitcnt vmcnt(0)" ::: "memory");
        }
    }
    __syncthreads();
}

using pg8::Unit;
struct EpiInProj {
    static constexpr bool PERM = true, AFTER_DRAIN = false; bf16 *U, *CQ, *CKV, *KR;
    __device__ __forceinline__ void operator()(const f32x4 (&acc)[2][2][4][2], const Unit& u, int wr_, int wc_, int fr_, int fq_) const {
        const int l_ = lane_id_v(), wr = wr_, wc = wc_, fr = l_ & 15, fq = l_ >> 4; (void)fr_; (void)fq_;
        const int row0 = u.pm * 256 + wr * 64 + fr;
#pragma unroll
        for (int bj = 0; bj < 2; ++bj) {
            const int c0 = u.pn * 256 + bj * 128 + wc * 32 + 8 * fq; bf16* base; int ld, cc;
            if (c0 < 512) { base = U; ld = 512; cc = c0; } else if (c0 < 896) { base = CQ; ld = 384; cc = c0 - 512; } else if (c0 < 1152) { base = CKV; ld = 256; cc = c0 - 896; }
            else if (c0 < 1184) { base = KR; ld = 32; cc = c0 - 1152; } else continue;
#pragma unroll
            for (int ai = 0; ai < 2; ++ai)
#pragma unroll
                for (int m = 0; m < 4; ++m) { const int row = row0 + ai * 128 + m * 16; *(u32x4*)(base + (size_t)row * ld + cc) = pack8(acc[ai][bj][m][0], acc[ai][bj][m][1]); }
        }
    }
};
struct EpiPlain {
    static constexpr bool PERM = true, AFTER_DRAIN = false; bf16* O; int ldc;
    __device__ __forceinline__ void operator()(const f32x4 (&acc)[2][2][4][2], const Unit& u, int wr_, int wc_, int fr_, int fq_) const {
        const int l_ = lane_id_v(), wr = wr_, wc = wc_, fr = l_ & 15, fq = l_ >> 4; (void)fr_; (void)fq_;
        const int row0 = u.pm * 256 + wr * 64 + fr;
#pragma unroll
        for (int bj = 0; bj < 2; ++bj) { const int c0 = u.pn * 256 + bj * 128 + wc * 32 + 8 * fq;
#pragma unroll
            for (int ai = 0; ai < 2; ++ai)
#pragma unroll
                for (int m = 0; m < 4; ++m) { const int row = row0 + ai * 128 + m * 16; *(u32x4*)(O + (size_t)row * ldc + c0) = pack8(acc[ai][bj][m][0], acc[ai][bj][m][1]); } }
    }
};
struct EpiQ {
    static constexpr bool PERM = true, AFTER_DRAIN = false; bf16* Q; const float* RSTD; const float* CS;
    __device__ __forceinline__ void operator()(const f32x4 (&acc)[2][2][4][2], const Unit& u, int wr_, int wc_, int fr_, int fq_) const {
        const int l_ = lane_id_v(), wr = wr_, wc = wc_, fr = l_ & 15, fq = l_ >> 4; (void)fr_; (void)fq_;
        const int row0 = u.pm * 256 + wr * 64 + fr;
#pragma unroll
        for (int ai = 0; ai < 2; ++ai)
#pragma unroll
            for (int m = 0; m < 4; ++m) { const int row = row0 + ai * 128 + m * 16; const float rs = RSTD[row * 2] * SCQ; const int b = row >> 12, s = row & 4095;
#pragma unroll
                for (int bj = 0; bj < 2; ++bj) { const int c0 = u.pn * 256 + bj * 128 + wc * 32 + 8 * fq; const int h = c0 / 96, d0 = c0 - h * 96;
                    f32x4 v0 = acc[ai][bj][m][0], v1 = acc[ai][bj][m][1];
                    if (d0 >= 64) { const int i = (d0 - 64) >> 1; const f32x4 c = *(const f32x4*)(CS + (size_t)row * 32 + i), sn = *(const f32x4*)(CS + (size_t)row * 32 + 16 + i);
                        f32x4 a, bb;
                        a[0] = v0[0] * c[0] - v0[1] * sn[0]; a[1] = v0[1] * c[0] + v0[0] * sn[0]; a[2] = v0[2] * c[1] - v0[3] * sn[1]; a[3] = v0[3] * c[1] + v0[2] * sn[1];
                        bb[0] = v1[0] * c[2] - v1[1] * sn[2]; bb[1] = v1[1] * c[2] + v1[0] * sn[2]; bb[2] = v1[2] * c[3] - v1[3] * sn[3]; bb[3] = v1[3] * c[3] + v1[2] * sn[3];
                        v0 = a; v1 = bb; }
                    v0 = v0 * rs; v1 = v1 * rs;
                    *(u32x4*)(Q + ((size_t)(b * NH + h) * SEQ + s) * QKD + d0) = pack8(v0, v1); }
                asm volatile("" ::: "memory"); }
    }
};
__device__ __forceinline__ int perm16(int k) { return (k & 3) | ((k & 4) << 1) | ((k & 8) >> 1); }
struct EpiKV {
    static constexpr bool PERM = true, AFTER_DRAIN = false; bf16 *K, *VT; const float* RSTD;
    __device__ __forceinline__ void operator()(const f32x4 (&acc)[2][2][4][2], const Unit& u, int wr_, int wc_, int fr_, int fq_) const {
        const int l_ = lane_id_v(), wr = wr_, wc = wc_, fr = l_ & 15, fq = l_ >> 4; (void)fr_; (void)fq_;
        const int row0 = u.pm * 256 + wr * 64 + fr;
#pragma unroll
        for (int ai = 0; ai < 2; ++ai)
#pragma unroll
            for (int m = 0; m < 4; ++m) { const int row = row0 + ai * 128 + m * 16; const float rs = RSTD[row * 2 + 1]; const int b = row >> 12, s = row & 4095;
#pragma unroll
                for (int bj = 0; bj < 2; ++bj) { const int c0 = u.pn * 256 + bj * 128 + wc * 32 + 8 * fq;
                    const u32x4 w = pack8(acc[ai][bj][m][0] * rs, acc[ai][bj][m][1] * rs);
                    if (c0 < 512) { const int h = c0 >> 6, d0 = c0 & 63; *(u32x4*)(K + ((size_t)(b * NH + h) * SEQ + s) * QKD + d0) = w; }
                    else { const int cc = c0 - 512, h = cc >> 6, dv0 = cc & 63; const int sp = (s & ~15) | perm16(s & 15);
                        bf16* p = VT + ((size_t)(b * NH + h) * VD + dv0) * SEQ + sp;
                        p[0 * SEQ] = (bf16)(w.x & 0xffffu); p[1 * SEQ] = (bf16)(w.x >> 16); p[2 * SEQ] = (bf16)(w.y & 0xffffu); p[3 * SEQ] = (bf16)(w.y >> 16);
                        p[4 * SEQ] = (bf16)(w.z & 0xffffu); p[5 * SEQ] = (bf16)(w.z >> 16); p[6 * SEQ] = (bf16)(w.w & 0xffffu); p[7 * SEQ] = (bf16)(w.w >> 16); }
                    asm volatile("" ::: "memory"); } }
    }
};
struct EpiResid {
    static constexpr bool PERM = true, AFTER_DRAIN = false; const float* R; float* Y;
    __device__ __forceinline__ void operator()(const f32x4 (&acc)[2][2][4][2], const Unit& u, int wr_, int wc_, int fr_, int fq_) const {
        const int l_ = lane_id_v(), wr = wr_, wc = wc_, fr = l_ & 15, fq = l_ >> 4; (void)fr_; (void)fq_;
        const int row0 = u.pm * 256 + wr * 64 + fr;
#pragma unroll
        for (int ai = 0; ai < 2; ++ai)
#pragma unroll
            for (int m = 0; m < 4; ++m) { const int row = row0 + ai * 128 + m * 16;
#pragma unroll
                for (int bj = 0; bj < 2; ++bj) { const size_t off = (size_t)row * D + u.pn * 256 + bj * 128 + wc * 32 + 8 * fq;
                    const f32x4 r0 = *(const f32x4*)(R + off), r1 = *(const f32x4*)(R + off + 4);
                    *(f32x4*)(Y + off) = r0 * ALPHA + acc[ai][bj][m][0]; *(f32x4*)(Y + off + 4) = r1 * ALPHA + acc[ai][bj][m][1]; } }
    }
};
__device__ __forceinline__ float silu_mul(float g, float up) { return g * __builtin_amdgcn_rcpf(1.f + __builtin_amdgcn_exp2f(-1.4426950408889634f * g)) * up; }
struct EpiSwiGLU {
    static constexpr bool PERM = true, AFTER_DRAIN = false; bf16* HB;
    __device__ __forceinline__ void operator()(const f32x4 (&acc)[2][2][4][2], const Unit& u, int wr_, int wc_, int fr_, int fq_) const {
        const int l_ = lane_id_v(), wr = wr_, wc = wc_, fr = l_ & 15, fq = l_ >> 4; (void)fr_; (void)fq_;
        const int row0 = u.pm * 256 + wr * 64 + fr, c0 = u.pn * 128 + wc * 32 + 8 * fq;
#pragma unroll
        for (int ai = 0; ai < 2; ++ai)
#pragma unroll
            for (int m = 0; m < 4; ++m) { const int row = row0 + ai * 128 + m * 16; f32x4 h0, h1;
#pragma unroll
                for (int e = 0; e < 4; ++e) { h0[e] = silu_mul(acc[ai][0][m][0][e], acc[ai][1][m][0][e]); h1[e] = silu_mul(acc[ai][0][m][1][e], acc[ai][1][m][1][e]); }
                *(u32x4*)(HB + (size_t)row * FF + c0) = pack8(h0, h1); }
    }
};

template <class SRC> __device__ __forceinline__ void tr_item(SRC src, bf16* WT, int ldt, int k0, int n0, LAS float* scr, int lane) {
#pragma unroll 8
    for (int i = 0; i < 32; ++i) { const int kk = 2 * i + (lane >> 5); scr[kk * 33 + (lane & 31)] = src(k0 + kk, n0 + (lane & 31)); }
    asm volatile("s_waitcnt lgkmcnt(0)" ::: "memory");
    const int c = lane & 7;
#pragma unroll
    for (int j = 0; j < 4; ++j) { const int n = (lane >> 3) + 8 * j; const LAS float* s = scr + (8 * c) * 33 + n;
        u32x4 o; o.x = pk2(s[0 * 33], s[1 * 33]); o.y = pk2(s[2 * 33], s[3 * 33]); o.z = pk2(s[4 * 33], s[5 * 33]); o.w = pk2(s[6 * 33], s[7 * 33]);
        *(u32x4*)(WT + (size_t)(n0 + n) * ldt + k0 + 8 * c) = o; }
    asm volatile("s_waitcnt lgkmcnt(0)" ::: "memory");
}
struct Ptrs {
    const float *x, *w_in, *pool_w, *pool_scale, *qg, *w_q_up, *kvg, *w_k_up, *w_v_up, *w_o, *ln1_g, *ln1_b, *w_gate, *w_up, *w_down, *ln2_g, *ln2_b; const int* pos;
    float* out; unsigned char* ws;
};
#define LAUNDER_TID() const int lane = lane_id_v(), t_l = wave * 64 + lane
__device__ __forceinline__ void p0_prologue(const Ptrs& P, LAS unsigned char* lds, int wave) {
    LAUNDER_TID();
    LAS float* scr = (LAS float*)(lds + wave * 16384);
    const int gw = blockIdx.x * NWAVES + wave, NGW = gridDim.x * NWAVES;
    unsigned char* ws = P.ws;
    bf16 *WinT = (bf16*)(ws + WS_WIN), *WpoolT = (bf16*)(ws + WS_WPOOL), *WqT = (bf16*)(ws + WS_WQ), *WkvT = (bf16*)(ws + WS_WKV), *WoT = (bf16*)(ws + WS_WO), *WguT = (bf16*)(ws + WS_WGU), *WdT = (bf16*)(ws + WS_WD);
    constexpr int I_IN = 16 * 40, I_POOL = 8 * 16, I_Q = 6 * 24, I_KV = 4 * 32, I_O = 16 * 32, I_GU = 16 * 176, I_D = 44 * 32;
    constexpr int NITEMS = I_IN + I_POOL + I_Q + I_KV + I_O + I_GU + I_D;
    for (int it = gw; it < NITEMS; it += NGW) {
        int r = it;
        if (r < I_IN) { const int kb = r / 40, nb = r % 40; const float* W = P.w_in;
            tr_item([=](int k, int n) { return n < INW ? W[(size_t)k * INW + n] : 0.f; }, WinT, D, 64 * kb, 32 * nb, scr, lane); continue; } r -= I_IN;
        if (r < I_POOL) { const int kb = r / 16, nb = r % 16; const float* W = P.pool_w; const float* sc = P.pool_scale; const int gk = kb >> 1, gn = nb >> 2;
            tr_item([=](int k, int n) { return gk == gn ? W[(size_t)gk * 16384 + (k & 127) * 128 + (n & 127)] * sc[n] : 0.f; }, WpoolT, 512, 64 * kb, 32 * nb, scr, lane); continue; } r -= I_POOL;
        if (r < I_Q) { const int kb = r / 24, nb = r % 24; const float* W = P.w_q_up; const float* g = P.qg;
            tr_item([=](int k, int n) { const int h = n / 96, d = n - h * 96; int src = n; if (d >= 64) { const int j = d - 64, i = j >> 1; src = h * 96 + 64 + ((j & 1) ? 16 + i : i); }
                return W[(size_t)k * 768 + src] * g[k]; }, WqT, QR, 64 * kb, 32 * nb, scr, lane); continue; } r -= I_Q;
        if (r < I_KV) { const int kb = r / 32, nb = r % 32; const float* Wk = P.w_k_up; const float* Wv = P.w_v_up; const float* g = P.kvg;
            tr_item([=](int k, int n) { return (n < 512 ? Wk[(size_t)k * 512 + n] : Wv[(size_t)k * 512 + n - 512]) * g[k]; }, WkvT, KVR, 64 * kb, 32 * nb, scr, lane); continue; } r -= I_KV;
        if (r < I_O) { const int kb = r / 32, nb = r % 32; const float* W = P.w_o;
            tr_item([=](int k, int n) { return W[(size_t)k * D + n]; }, WoT, D, 64 * kb, 32 * nb, scr, lane); continue; } r -= I_O;
        if (r < I_GU) { const int kb = r / 176, nb = r % 176; const float* Wg = P.w_gate; const float* Wu = P.w_up;
            tr_item([=](int k, int n) { const int pn = n >> 8, w = n & 255; return w < 128 ? Wg[(size_t)k * FF + pn * 128 + w] : Wu[(size_t)k * FF + pn * 128 + w - 128]; }, WguT, D, 64 * kb, 32 * nb, scr, lane); continue; } r -= I_GU;
        { const int kb = r / 32, nb = r % 32; const float* W = P.w_down;
            tr_item([=](int k, int n) { return W[(size_t)k * D + n]; }, WdT, FF, 64 * kb, 32 * nb, scr, lane); }
    }
    bf16* XB = (bf16*)(ws + WS_XB);
    const int gt = blockIdx.x * 512 + t_l, NT = gridDim.x * 512;
    for (int c = gt; c < M * D / 8; c += NT) { const f32x4 a = *(const f32x4*)(P.x + (size_t)c * 8), b = *(const f32x4*)(P.x + (size_t)c * 8 + 4); *(u32x4*)(XB + (size_t)c * 8) = pack8(a, b); }
}

__device__ __forceinline__ void unpack_add(float (&a)[8], u32x4 w) { a[0] += bflo(w.x); a[1] += bfhi(w.x); a[2] += bflo(w.y); a[3] += bfhi(w.y); a[4] += bflo(w.z); a[5] += bfhi(w.z); a[6] += bflo(w.w); a[7] += bfhi(w.w); }
__device__ __forceinline__ float sumsq8(u32x4 w) { float s = 0.f; float v;
    v = bflo(w.x); s += v * v; v = bfhi(w.x); s += v * v; v = bflo(w.y); s += v * v; v = bfhi(w.y); s += v * v; v = bflo(w.z); s += v * v; v = bfhi(w.z); s += v * v; v = bflo(w.w); s += v * v; v = bfhi(w.w); s += v * v; return s; }
__device__ __forceinline__ void rope_cs(int pos, int i, float& c, float& s) {
    const double f = i == 0 ? 1.0 : i == 1 ? 0.5623413251903491 : i == 2 ? 0.31622776601683794 : i == 3 ? 0.1778279410038923 : i == 4 ? 0.1 : i == 5 ? 0.05623413251903491 : i == 6 ? 0.03162277660168379 : i == 7 ? 0.01778279410038923
                   : i == 8 ? 0.01 : i == 9 ? 0.005623413251903491 : i == 10 ? 0.0031622776601683794 : i == 11 ? 0.0017782794100389228 : i == 12 ? 0.001 : i == 13 ? 0.0005623413251903491 : i == 14 ? 0.00031622776601683794 : 0.00017782794100389227;
    const double t = (double)pos * f * 0.15915494309189535;
    const float rev = (float)(t - rint(t));
    c = __builtin_amdgcn_cosf(rev); s = __builtin_amdgcn_sinf(rev);
}
__device__ __forceinline__ void p2_tokens(const Ptrs& P, int wave) {
    LAUNDER_TID(); (void)t_l;
    unsigned char* ws = P.ws;
    const bf16 *U = (const bf16*)(ws + WS_U), *CQ = (const bf16*)(ws + WS_CQ), *CKV = (const bf16*)(ws + WS_CKV), *KR = (const bf16*)(ws + WS_KR);
    bf16 *PG = (bf16*)(ws + WS_PG), *K = (bf16*)(ws + WS_K); float *CS = (float*)(ws + WS_CS), *RSTD = (float*)(ws + WS_RSTD);
    const int gw = blockIdx.x * NWAVES + wave, NGW = gridDim.x * NWAVES;
    for (int m = gw; m < M; m += NGW) {
        const int s = m & (SEQ - 1), b0 = m - s, b = m >> 12;
        { const int g = lane >> 4, w = 2 << g; int lo = s - (w >> 1); if (lo < 0) lo = 0; int hi = s + w - (w >> 1); if (hi > SEQ) hi = SEQ;
          float a[8] = {0.f, 0.f, 0.f, 0.f, 0.f, 0.f, 0.f, 0.f};
          for (int j = lo; j < hi; ++j) unpack_add(a, *(const u32x4*)(U + (size_t)(b0 + j) * POOLW + lane * 8));
          float sf[8] = {0.f, 0.f, 0.f, 0.f, 0.f, 0.f, 0.f, 0.f}; unpack_add(sf, *(const u32x4*)(U + (size_t)m * POOLW + lane * 8));
          const float inv = 1.f / (float)(hi - lo);
          u32x4 o; o.x = pk2(a[0] * inv - sf[0], a[1] * inv - sf[1]); o.y = pk2(a[2] * inv - sf[2], a[3] * inv - sf[3]); o.z = pk2(a[4] * inv - sf[4], a[5] * inv - sf[5]); o.w = pk2(a[6] * inv - sf[6], a[7] * inv - sf[7]);
          *(u32x4*)(PG + (size_t)m * POOLW + lane * 8) = o; }
        { float sq = 0.f; if (lane < 48) sq = sumsq8(*(const u32x4*)(CQ + (size_t)m * QR + lane * 8));
          float sk = 0.f; if (lane < 32) sk = sumsq8(*(const u32x4*)(CKV + (size_t)m * KVR + lane * 8));
          sq = wave_sum(sq); sk = wave_sum(sk);
          if (lane == 0) { RSTD[m * 2] = 1.f / sqrtf(sq * (1.f / QR) + RMS_EPS); RSTD[m * 2 + 1] = 1.f / sqrtf(sk * (1.f / KVR) + RMS_EPS); } }
        { const int hd = lane >> 3, ii = lane & 7, i0 = 2 * ii, i1 = i0 + 1; const int pos = P.pos[m];
          float c0, s0, c1, s1; rope_cs(pos, i0, c0, s0); rope_cs(pos, i1, c1, s1);
          const unsigned w1 = *(const unsigned*)(KR + (size_t)m * 32 + i0), w2 = *(const unsigned*)(KR + (size_t)m * 32 + 16 + i0);
          const float t1a = bflo(w1), t1b = bfhi(w1), t2a = bflo(w2), t2b = bfhi(w2);
          u32x2 o; o.x = pk2(t1a * c0 - t2a * s0, t2a * c0 + t1a * s0); o.y = pk2(t1b * c1 - t2b * s1, t2b * c1 + t1b * s1);
          *(u32x2*)(K + ((size_t)(b * NH + hd) * SEQ + s) * QKD + 64 + 4 * ii) = o;
          if (hd == 0) { float* cs = CS + (size_t)m * 32; cs[i0] = c0; cs[i1] = c1; cs[16 + i0] = s0; cs[16 + i1] = s1; } }
    }
}

template <bool WB> __device__ __forceinline__ void ln_phase(const float* Y, float* O, bf16* OB, const float* g, const float* bta, int wave) {
    LAUNDER_TID(); (void)t_l;
    const int gw = blockIdx.x * NWAVES + wave, NGW = gridDim.x * NWAVES;
    f32x4 gv[4], bv[4];
#pragma unroll
    for (int j = 0; j < 4; ++j) { gv[j] = *((const f32x4*)g + lane + 64 * j); bv[j] = *((const f32x4*)bta + lane + 64 * j); }
    for (int m = gw; m < M; m += NGW) {
        const f32x4* yr = (const f32x4*)(Y + (size_t)m * D) + lane; f32x4 v[4]; float s = 0.f;
#pragma unroll
        for (int j = 0; j < 4; ++j) { v[j] = yr[64 * j]; s += (v[j].x + v[j].y) + (v[j].z + v[j].w); }
        const float mean = wave_sum(s) * (1.f / D); float s2 = 0.f;
#pragma unroll
        for (int j = 0; j < 4; ++j) { v[j] = v[j] - mean; s2 += (v[j].x * v[j].x + v[j].y * v[j].y) + (v[j].z * v[j].z + v[j].w * v[j].w); }
        const float rstd = 1.f / sqrtf(wave_sum(s2) * (1.f / D) + LN_EPS);
#pragma unroll
        for (int j = 0; j < 4; ++j) { const f32x4 o = v[j] * rstd * gv[j] + bv[j]; *((f32x4*)(O + (size_t)m * D) + lane + 64 * j) = o;
            if (WB) { u32x2 w; w.x = pk2(o.x, o.y); w.y = pk2(o.z, o.w); *((u32x2*)(OB + (size_t)m * D) + lane + 64 * j) = w; } }
    }
}

namespace att {
constexpr int KROW = 208, VROW = 144, KT_BYTES = 64 * KROW, VT_BYTES = 64 * VROW, BUF = KT_BYTES + VT_BYTES;
__device__ __forceinline__ bf16x8 pk8(const f32x16& p, int o) {
    u32x4 w; w.x = pk2(p[o + 0], p[o + 1]); w.y = pk2(p[o + 2], p[o + 3]); w.z = pk2(p[o + 4], p[o + 5]); w.w = pk2(p[o + 6], p[o + 7]); return __builtin_bit_cast(bf16x8, w); }
__device__ __forceinline__ void attn_unit(LAS unsigned char* lds, const bf16* Qg, const bf16* Kg, const bf16* VTg, bf16* CAT, int b, int h, int qb, int wave) {
    const int lane = lane_id_v(), wid = wave, tid = wid * 64 + lane, r = lane & 31, hh = lane >> 5;
    const bf16* Qh = Qg + ((size_t)(b * NH + h) * SEQ + qb * 256 + wid * 32) * QKD;
    const bf16* Kh = Kg + (size_t)(b * NH + h) * SEQ * QKD;
    const bf16* Vh = VTg + (size_t)(b * NH + h) * VD * SEQ;
    bf16x8 qf[6];
#pragma unroll
    for (int ks = 0; ks < 6; ++ks) qf[ks] = *(const bf16x8*)(Qh + r * QKD + ks * 16 + hh * 8);
    const int kc1 = 512 + tid;
    const int koff0 = (tid / 12) * KROW + (tid % 12) * 16, koff1 = (kc1 / 12) * KROW + (kc1 % 12) * 16, voff = KT_BYTES + (tid >> 3) * VROW + (tid & 7) * 16;
    const bf16* kg0 = Kh + tid * 8; const bf16* kg1 = Kh + kc1 * 8; const bf16* vg = Vh + (size_t)(tid >> 3) * SEQ + (tid & 7) * 8;
    u32x4 kr0, kr1 = {0u, 0u, 0u, 0u}, vr;
    kr0 = *(const u32x4*)kg0; if (tid < 256) kr1 = *(const u32x4*)kg1; vr = *(const u32x4*)vg;
    *(LAS u32x4*)(lds + koff0) = kr0; if (tid < 256) *(LAS u32x4*)(lds + koff1) = kr1; *(LAS u32x4*)(lds + voff) = vr;
    __syncthreads();
    float mrow = -1e30f, lsum = 0.f; f32x16 o0 = {}, o1 = {};
    const int kread = r * KROW + hh * 16, vread = KT_BYTES + r * VROW + hh * 16;
    for (int t = 0; t < SEQ / 64; ++t) {
        const bool more = (t + 1 < SEQ / 64);
        if (more) { kr0 = *(const u32x4*)(kg0 + (size_t)(t + 1) * 64 * QKD); if (tid < 256) kr1 = *(const u32x4*)(kg1 + (size_t)(t + 1) * 64 * QKD); vr = *(const u32x4*)(vg + (t + 1) * 64); }
        LAS unsigned char* cur = lds + (t & 1) * BUF;
        f32x16 p0 = {}, p1 = {};
#pragma unroll
        for (int ks = 0; ks < 6; ++ks) {
            const bf16x8 a0 = *(const LAS bf16x8*)(cur + kread + ks * 32), a1 = *(const LAS bf16x8*)(cur + kread + 32 * KROW + ks * 32);
            p0 = __builtin_amdgcn_mfma_f32_32x32x16_bf16(a0, qf[ks], p0, 0, 0, 0); p1 = __builtin_amdgcn_mfma_f32_32x32x16_bf16(a1, qf[ks], p1, 0, 0, 0);
        }
        float tmax = fmaxf(p0[0], p1[0]);
#pragma unroll
        for (int e = 1; e < 16; ++e) tmax = fmaxf(tmax, fmaxf(p0[e], p1[e]));
        tmax = fmaxf(tmax, __shfl_xor(tmax, 32));
        const float mnew = fmaxf(mrow, tmax), alpha = __builtin_amdgcn_exp2f(mrow - mnew); mrow = mnew;
        float ps = 0.f;
#pragma unroll
        for (int e = 0; e < 16; ++e) { p0[e] = __builtin_amdgcn_exp2f(p0[e] - mnew); p1[e] = __builtin_amdgcn_exp2f(p1[e] - mnew); ps += p0[e] + p1[e]; }
        lsum = lsum * alpha + ps;
#pragma unroll
        for (int e = 0; e < 16; ++e) { o0[e] *= alpha; o1[e] *= alpha; }
        bf16x8 pf[4]; pf[0] = pk8(p0, 0); pf[1] = pk8(p0, 8); pf[2] = pk8(p1, 0); pf[3] = pk8(p1, 8);
#pragma unroll
        for (int ks = 0; ks < 4; ++ks) {
            const bf16x8 v0 = *(const LAS bf16x8*)(cur + vread + ks * 32), v1 = *(const LAS bf16x8*)(cur + vread + 32 * VROW + ks * 32);
            o0 = __builtin_amdgcn_mfma_f32_32x32x16_bf16(v0, pf[ks], o0, 0, 0, 0); o1 = __builtin_amdgcn_mfma_f32_32x32x16_bf16(v1, pf[ks], o1, 0, 0, 0);
        }
        if (more) { LAS unsigned char* nxt = lds + ((t + 1) & 1) * BUF; *(LAS u32x4*)(nxt + koff0) = kr0; if (tid < 256) *(LAS u32x4*)(nxt + koff1) = kr1; *(LAS u32x4*)(nxt + voff) = vr; }
        __syncthreads();
    }
    const float inv = 1.f / (lsum + __shfl_xor(lsum, 32));
    bf16* orow = CAT + (size_t)(b * SEQ + qb * 256 + wid * 32 + r) * D + 512 + h * VD + 4 * hh;
#pragma unroll
    for (int g = 0; g < 4; ++g) {
        u32x2 w; w.x = pk2(o0[4 * g] * inv, o0[4 * g + 1] * inv); w.y = pk2(o0[4 * g + 2] * inv, o0[4 * g + 3] * inv); *(u32x2*)(orow + 8 * g) = w;
        u32x2 w2; w2.x = pk2(o1[4 * g] * inv, o1[4 * g + 1] * inv); w2.y = pk2(o1[4 * g + 2] * inv, o1[4 * g + 3] * inv); *(u32x2*)(orow + 32 + 8 * g) = w2;
    }
}
}

struct Args { const void* in[18]; float* out; unsigned char* ws; int ph_lo, ph_hi; };
constexpr int N_PHASES = 10;
__global__ void __launch_bounds__(NWAVES * 64, 2) mega_fwd(Args args) {
    extern __shared__ __attribute__((aligned(16))) unsigned char lds_raw[];
    LAS unsigned char* lds = (LAS unsigned char*)lds_raw;
    cg::grid_group grid = cg::this_grid();
    const int wave = __builtin_amdgcn_readfirstlane(threadIdx.x >> 6);
    const int G = gridDim.x, cu = blockIdx.x;
    volatile LAS unsigned* MISC = (volatile LAS unsigned*)(lds + 131072);
    if (threadIdx.x < 64) MISC[threadIdx.x] = 0u;
    __syncthreads();
    XcdBarrier bar = xcd_barrier_post((unsigned*)args.ws + 1024, MISC + 8, threadIdx.x == 0);
    Ptrs P;
    P.x = (const float*)args.in[0]; P.pos = (const int*)args.in[1]; P.w_in = (const float*)args.in[2]; P.pool_w = (const float*)args.in[3]; P.pool_scale = (const float*)args.in[4];
    P.qg = (const float*)args.in[5]; P.w_q_up = (const float*)args.in[6]; P.kvg = (const float*)args.in[7]; P.w_k_up = (const float*)args.in[8]; P.w_v_up = (const float*)args.in[9];
    P.w_o = (const float*)args.in[10]; P.ln1_g = (const float*)args.in[11]; P.ln1_b = (const float*)args.in[12]; P.w_gate = (const float*)args.in[13]; P.w_up = (const float*)args.in[14];
    P.w_down = (const float*)args.in[15]; P.ln2_g = (const float*)args.in[16]; P.ln2_b = (const float*)args.in[17]; P.out = args.out; P.ws = args.ws;
    unsigned char* ws = args.ws;
    bf16 *WinT = (bf16*)(ws + WS_WIN), *WpoolT = (bf16*)(ws + WS_WPOOL), *WqT = (bf16*)(ws + WS_WQ), *WkvT = (bf16*)(ws + WS_WKV), *WoT = (bf16*)(ws + WS_WO), *WguT = (bf16*)(ws + WS_WGU), *WdT = (bf16*)(ws + WS_WD);
    bf16 *XB = (bf16*)(ws + WS_XB), *U = (bf16*)(ws + WS_U), *CQ = (bf16*)(ws + WS_CQ), *CKV = (bf16*)(ws + WS_CKV), *KR = (bf16*)(ws + WS_KR), *PG = (bf16*)(ws + WS_PG);
    bf16 *CAT = (bf16*)(ws + WS_CAT), *Qb = (bf16*)(ws + WS_Q), *Kb = (bf16*)(ws + WS_K), *VTb = (bf16*)(ws + WS_VT), *X1B = (bf16*)(ws + WS_X1B), *HB = (bf16*)(ws + WS_HB);
    float *CS = (float*)(ws + WS_CS), *RSTD = (float*)(ws + WS_RSTD), *Y1 = (float*)(ws + WS_Y1);
    const int lo = args.ph_lo, hi = args.ph_hi;
#ifndef MK_MASK
#define MK_MASK 0x3ff
#endif
#define IN(k) (((MK_MASK >> (k)) & 1) && lo <= (k) && (k) < hi)
#define SEAM(k) do { if (IN(k) && IN((k) + 1)) { if ((k) == 0) grid.sync(); else xcd_barrier(bar, wave == 0 && lane_id_v() == 0); } } while (0)
    typedef pg8::StaticOrder SO;
    if (IN(0)) { p0_prologue(P, lds, wave); } SEAM(0);
    if (IN(1)) { pg8::Gemm g{XB, WinT, M, INWP, D}; SO S; S.init(M, INWP, G, cu); EpiInProj E{U, CQ, CKV, KR};
        pg8::gemm_phase<EpiInProj, SO, true, true>(lds, g, S, E, wave); } SEAM(1);
    if (IN(2)) { p2_tokens(P, wave); } SEAM(2);
    if (IN(3)) {
#ifndef MK_P3
#define MK_P3 7
#endif
        if (MK_P3 & 1) { pg8::Gemm g{PG, WpoolT, M, POOLW, POOLW}; SO S; S.init(M, POOLW, G, cu); EpiPlain E{CAT, D}; pg8::gemm_phase<EpiPlain, SO, true, true>(lds, g, S, E, wave); }
        if (MK_P3 & 2) { pg8::Gemm g{CQ, WqT, M, NH * QKD, QR}; SO S; S.init(M, NH * QKD, G, (cu + 128) % G); EpiQ E{Qb, RSTD, CS}; pg8::gemm_phase<EpiQ, SO, true, true>(lds, g, S, E, wave); }
        if (MK_P3 & 4) { pg8::Gemm g{CKV, WkvT, M, 1024, KVR}; SO S; S.init(M, 1024, G, cu); EpiKV E{Kb, VTb, RSTD}; pg8::gemm_phase<EpiKV, SO, true, true>(lds, g, S, E, wave); }
    } SEAM(3);
    if (IN(4)) {
        const int xcd = cu & 7, slot = cu >> 3;
        for (int uidx = slot; uidx < 64; uidx += (G >> 3)) { const int bh = xcd * 4 + (uidx >> 4), qb = uidx & 15;
            att::attn_unit(lds, Qb, Kb, VTb, CAT, bh >> 3, bh & 7, qb, wave); }
    } SEAM(4);
    if (IN(5)) { pg8::Gemm g{CAT, WoT, M, D, D}; SO S; S.init(M, D, G, cu); EpiResid E{P.x, Y1}; pg8::gemm_phase<EpiResid, SO, true, true>(lds, g, S, E, wave); } SEAM(5);
    if (IN(6)) { ln_phase<true>(Y1, Y1, X1B, P.ln1_g, P.ln1_b, wave); } SEAM(6);
    if (IN(7)) { pg8::Gemm g{X1B, WguT, M, 2 * FF, D}; SO S; S.init(M, 2 * FF, G, cu); EpiSwiGLU E{HB}; pg8::gemm_phase<EpiSwiGLU, SO, true, true>(lds, g, S, E, wave); } SEAM(7);
    if (IN(8)) { pg8::Gemm g{HB, WdT, M, D, FF}; SO S; S.init(M, D, G, cu); EpiResid E{Y1, P.out}; pg8::gemm_phase<EpiResid, SO, true, true>(lds, g, S, E, wave); } SEAM(8);
    if (IN(9)) { ln_phase<false>(P.out, P.out, nullptr, P.ln2_g, P.ln2_b, wave); }
#undef IN
#undef SEAM
}

extern "C" void kernel_launch(void* const* d_in, const int* in_sizes, int n_in, void* d_out, int out_size, void* d_ws, size_t ws_size, hipStream_t stream) {
    static int grid = 0;
    if (grid == 0) {
        if (n_in != 18 || in_sizes[0] != M * D || out_size != M * D || ws_size < WS_END) { fprintf(stderr, "kernel_launch: unexpected shapes (n_in %d, ws %zu)\n", n_in, ws_size); grid = -1; return; }
        int dev = 0, cus = 0, per_cu = 0;
        hipGetDevice(&dev); hipDeviceGetAttribute(&cus, hipDeviceAttributeMultiprocessorCount, dev);
        if (hipFuncSetAttribute((const void*)mega_fwd, hipFuncAttributeMaxDynamicSharedMemorySize, LDS_BYTES) != hipSuccess) { fprintf(stderr, "kernel_launch: hipFuncSetAttribute failed\n"); grid = -1; return; }
        if (hipOccupancyMaxActiveBlocksPerMultiprocessor(&per_cu, (const void*)mega_fwd, NWAVES * 64, LDS_BYTES) != hipSuccess || per_cu < 1) { fprintf(stderr, "kernel_launch: occupancy query says %d blocks per CU\n", per_cu); grid = -1; return; }
        grid = cus;
        if (grid > 256) grid = 256;
    }
    if (grid < 0) return;
    if (hipMemsetAsync(d_ws, 0, 65536, stream) != hipSuccess) { fprintf(stderr, "kernel_launch: memset failed\n"); return; }
    Args a{};
    for (int i = 0; i < 18; ++i) a.in[i] = d_in[i];
    a.out = (float*)d_out; a.ws = (unsigned char*)d_ws;
#if MK_PER_PHASE
    for (int p = 0; p < N_PHASES; ++p) { a.ph_lo = p; a.ph_hi = p + 1; void* kargs[] = {&a};
        hipError_t e = hipLaunchCooperativeKernel((const void*)mega_fwd, dim3(grid), dim3(NWAVES * 64), kargs, LDS_BYTES, stream);
        if (e != hipSuccess) { fprintf(stderr, "kernel_launch: cooperative launch (phase %d) failed: %s\n", p, hipGetErrorString(e)); break; } }
#else
    a.ph_lo = 0; a.ph_hi = N_PHASES; void* kargs[] = {&a};
    hipError_t e = hipLaunchCooperativeKernel((const void*)mega_fwd, dim3(grid), dim3(NWAVES * 64), kargs, LDS_BYTES, stream);
    if (e != hipSuccess) fprintf(stderr, "kernel_launch: cooperative launch failed: %s (grid %d)\n", hipGetErrorString(e), grid);
#endif
}
```

```cpp
#include <hip/hip_runtime.h>
#include <hip/hip_cooperative_groups.h>
#include <cstdio>
#include <cstdint>
#include <cmath>
namespace cg = cooperative_groups;
__device__ __forceinline__ int lane_id_v() { int l; asm volatile("v_mbcnt_lo_u32_b32 %0, -1, 0\n\tv_mbcnt_hi_u32_b32 %0, -1, %0" : "=v"(l)); return l; }
namespace pg8 {
#define PG8_LAS __attribute__((address_space(3)))
typedef unsigned short bf16_t;
typedef short bf16x8 __attribute__((ext_vector_type(8)));
typedef float f32x4 __attribute__((ext_vector_type(4)));
typedef unsigned u32x4 __attribute__((ext_vector_type(4)));
constexpr int BM = 256, BK = 64, HALF = 128, HTB = HALF * BK * 2  , STAGE_BYTES = 8 * HTB, NXCD = 8, WGM = 8;

__host__ __device__ __forceinline__ int lds_byte(int r, int c) { const int st = (r >> 4) * 2 + (c >> 5), rr = r & 15, cc = c & 31, ob = rr * 64 + cc * 2; return st * 1024 + (ob ^ (((ob >> 9) & 1) << 5)); }
__host__ __device__ __forceinline__ void stage_rc(int b, int& R, int& C) { const int st = b / 1024, sb = b % 1024, swz = sb ^ (((sb >> 9) & 1) << 5); R = (st >> 1) * 16 + swz / 64; C = (st & 1) * 32 + (swz % 64) / 2; }
__host__ __device__ __forceinline__ int perm32(int rho) { const int n = rho >> 4, i = rho & 15; return 8 * (i >> 2) + 4 * n + (i & 3); }

struct Unit { int pm, pn; };
struct Gemm { const bf16_t* A; const bf16_t* Bt; int M, N, K; };

struct StaticOrder {
    int nM, nN, nwg, G, c;
    __host__ __device__ void init(int M, int N, int G_, int c_) { nM = M / BM; nN = N / BM; nwg = nM * nN; G = G_; c = c_; }
    __host__ __device__ bool next(int i, Unit& u) const {
        const long L = (long)i * G + c; if (L >= nwg) return false;
        int wgid = (int)L; { const int q = nwg / NXCD, r = nwg % NXCD, xcd = wgid % NXCD, off = wgid / NXCD; wgid = (xcd < r ? xcd * (q + 1) : r * (q + 1) + (xcd - r) * q) + off; }
        const int nig = WGM * nN, gid = wgid / nig, fm = gid * WGM, gsz = (nM - fm) < WGM ? (nM - fm) : WGM;
        u.pm = fm + ((wgid % nig) % gsz); u.pn = (wgid % nig) / gsz; return true;
    }
    __device__ __forceinline__ void a_ready(const Unit&) const {}
    __device__ __forceinline__ void done(const Unit&) const {}
};

__device__ __forceinline__ unsigned cvt_pk_bf16(float lo, float hi) { unsigned r; asm volatile("v_cvt_pk_bf16_f32 %0, %1, %2" : "=v"(r) : "v"(lo), "v"(hi)); return r; }
template <class Epi, class Sched, bool ALIGN_EPI = false, bool SP2 = false>
__device__ __forceinline__ void gemm_phase(PG8_LAS unsigned char* lds, const Gemm g, const Sched& S, const Epi& E, int wave_in) {
    const int tid_l = wave_in * 64 + lane_id_v();
    const int tid = tid_l, wid = __builtin_amdgcn_readfirstlane(tid >> 6), lane = tid & 63, wr = wid >> 2, wc = wid & 3, fr = lane & 15, fq = lane >> 4;
    const int K = g.K, nt = K / BK;
    unsigned voffA[2], voffB[2];
#pragma unroll
    for (int i = 0; i < 2; ++i) { int R, C; stage_rc(tid * 16 + i * 8192, R, C); const int Rb = Epi::PERM ? ((R & ~31) + perm32(R & 31)) : R;
        voffA[i] = (unsigned)(R * K + C) * 2u; voffB[i] = (unsigned)(Rb * K + C) * 2u; }
    const size_t kstep = (size_t)(BK * 2);
    const size_t hstep = (size_t)HALF * K * 2;
    const size_t tstep = 2 * hstep;
    const unsigned ldsw = (unsigned)wid * 1024u;
    const int aoff = lds_byte(wr * 64 + fr, fq * 8), boff = lds_byte(wc * 32 + fr, fq * 8);
#define PG8_SA(b, h) (((b) * 2 + (h)) * HTB)
#define PG8_SB(b, h) ((4 + (b) * 2 + (h)) * HTB)
#define PG8_STAGE(bufoff, gbase, voff) do { _Pragma("unroll") for (int _i = 0; _i < 2; ++_i) \
        __builtin_amdgcn_global_load_lds((const unsigned*)((const char*)(gbase) + (voff)[_i]), (PG8_LAS unsigned*)(lds + (bufoff) + ldsw + _i * 8192), 16, 0, 0); } while (0)
#define PG8_LDA(dst, b, h) do { _Pragma("unroll") for (int m = 0; m < 4; ++m) _Pragma("unroll") for (int k = 0; k < 2; ++k) dst[m][k] = *(const PG8_LAS bf16x8*)(lds + PG8_SA(b, h) + aoff + m * 2048 + k * 1024); } while (0)
#define PG8_LDB(dst, b, h) do { _Pragma("unroll") for (int n = 0; n < 2; ++n) _Pragma("unroll") for (int k = 0; k < 2; ++k) dst[n][k] = *(const PG8_LAS bf16x8*)(lds + PG8_SB(b, h) + boff + n * 2048 + k * 1024); } while (0)
#define PG8_MMA(ai, bj, At, Bt) do { __builtin_amdgcn_s_setprio(1); _Pragma("unroll") for (int m = 0; m < 4; ++m) _Pragma("unroll") for (int n = 0; n < 2; ++n) _Pragma("unroll") for (int k = 0; k < 2; ++k) \
        acc[ai][bj][m][n] = __builtin_amdgcn_mfma_f32_16x16x32_bf16(Bt[n][k], At[m][k], acc[ai][bj][m][n], 0, 0, 0); __builtin_amdgcn_s_setprio(0); } while (0)
#define PG8_WAIT_V(n) asm volatile("s_waitcnt vmcnt(" #n ")" ::: "memory")
#define PG8_WAIT_L(n) asm volatile("s_waitcnt lgkmcnt(" #n ")" ::: "memory")
#define PG8_BAR __builtin_amdgcn_s_barrier()
#define PG8_SCHED __builtin_amdgcn_sched_barrier(0)
    Unit cur, nxt; int ui = 0;
    if (!S.next(0, cur)) return;
    f32x4 acc[2][2][4][2];
#pragma unroll
    for (int a = 0; a < 2; ++a)
#pragma unroll
        for (int b = 0; b < 2; ++b)
#pragma unroll
            for (int m = 0; m < 4; ++m)
#pragma unroll
                for (int n = 0; n < 2; ++n) acc[a][b][m][n] = (f32x4){0.f, 0.f, 0.f, 0.f};
    bf16x8 At[4][2], B0[2][2], B1[2][2];
    const char* cA = (const char*)g.A + (size_t)cur.pm * tstep; const char* cB = (const char*)g.Bt + (size_t)cur.pn * tstep;
    S.a_ready(cur);
    if constexpr (SP2) {
        PG8_STAGE(PG8_SB(0, 0), cB, voffB); PG8_STAGE(PG8_SB(0, 1), cB + hstep, voffB); PG8_STAGE(PG8_SA(0, 0), cA, voffA); PG8_STAGE(PG8_SA(0, 1), cA + hstep, voffA);
        if (wr == 1) PG8_BAR;
        PG8_WAIT_V(2); PG8_BAR;
        PG8_STAGE(PG8_SB(1, 0), cB + kstep, voffB); PG8_STAGE(PG8_SA(1, 0), cA + kstep, voffA); PG8_STAGE(PG8_SB(1, 1), cB + hstep + kstep, voffB);
        PG8_WAIT_V(6); PG8_BAR;
    } else {
        PG8_STAGE(PG8_SB(0, 0), cB, voffB); PG8_STAGE(PG8_SA(0, 0), cA, voffA); PG8_STAGE(PG8_SB(0, 1), cB + hstep, voffB); PG8_STAGE(PG8_SA(0, 1), cA + hstep, voffA);
        if (wr == 1) PG8_BAR;
        PG8_WAIT_V(4); PG8_BAR;
        PG8_STAGE(PG8_SB(1, 0), cB + kstep, voffB); PG8_STAGE(PG8_SA(1, 0), cA + kstep, voffA); PG8_STAGE(PG8_SB(1, 1), cB + hstep + kstep, voffB);
        PG8_WAIT_V(6); PG8_BAR;
    }
    for (;;) {
        const bool has_next = S.next(ui + 1, nxt);
        const char* nA = has_next ? (const char*)g.A + (size_t)nxt.pm * tstep : cA; const char* nB = has_next ? (const char*)g.Bt + (size_t)nxt.pn * tstep : cB;
        for (int t = 0; t < nt; t += 2) {
            const bool last = (t == nt - 2);
            const char* a1 = cA + (size_t)(t + 1) * kstep;
            const char* a2 = last ? nA : cA + (size_t)(t + 2) * kstep; const char* b2 = last ? nB : cB + (size_t)(t + 2) * kstep;
            const char* a3 = a2 + kstep; const char* b3 = b2 + kstep;
            if (last && has_next) S.a_ready(nxt);
            if constexpr (SP2) {
            PG8_LDB(B0, 0, 0); PG8_LDB(B1, 0, 1); PG8_SCHED; PG8_LDA(At, 0, 0); PG8_STAGE(PG8_SA(1, 1), a1 + hstep, voffA);
            PG8_WAIT_V(8); PG8_WAIT_L(0); PG8_BAR; PG8_MMA(0, 0, At, B0); PG8_MMA(0, 1, At, B1); PG8_BAR; PG8_SCHED;
            PG8_LDA(At, 0, 1); PG8_STAGE(PG8_SB(0, 0), b2, voffB); PG8_STAGE(PG8_SB(0, 1), b2 + hstep, voffB); PG8_STAGE(PG8_SA(0, 0), a2, voffA);
            PG8_WAIT_V(8); PG8_WAIT_L(0); PG8_BAR; PG8_MMA(1, 0, At, B0); PG8_MMA(1, 1, At, B1); PG8_BAR; PG8_SCHED;
            PG8_LDB(B0, 1, 0); PG8_LDB(B1, 1, 1); PG8_SCHED; PG8_LDA(At, 1, 0); PG8_STAGE(PG8_SA(0, 1), a2 + hstep, voffA);
            PG8_WAIT_V(8); PG8_WAIT_L(0); PG8_BAR; PG8_MMA(0, 0, At, B0); PG8_MMA(0, 1, At, B1); PG8_BAR; PG8_SCHED;
            PG8_LDA(At, 1, 1); PG8_STAGE(PG8_SB(1, 0), b3, voffB); PG8_STAGE(PG8_SB(1, 1), b3 + hstep, voffB); PG8_STAGE(PG8_SA(1, 0), a3, voffA);
            PG8_WAIT_V(8); PG8_WAIT_L(0); PG8_BAR; PG8_MMA(1, 0, At, B0); PG8_MMA(1, 1, At, B1); PG8_BAR; PG8_SCHED;
            } else {
            PG8_LDB(B0, 0, 0); PG8_SCHED; PG8_LDA(At, 0, 0); PG8_STAGE(PG8_SA(1, 1), a1 + hstep, voffA);
            PG8_WAIT_L(8); PG8_BAR; PG8_WAIT_L(0); PG8_MMA(0, 0, At, B0); PG8_BAR; PG8_SCHED;
            PG8_LDB(B1, 0, 1); PG8_STAGE(PG8_SB(0, 0), b2, voffB);
            PG8_BAR; PG8_WAIT_L(0); PG8_MMA(0, 1, At, B1); PG8_BAR;
            PG8_LDA(At, 0, 1); PG8_STAGE(PG8_SA(0, 0), a2, voffA);
            PG8_BAR; PG8_WAIT_L(0); PG8_MMA(1, 0, At, B0); PG8_BAR; PG8_SCHED;
            PG8_STAGE(PG8_SB(0, 1), b2 + hstep, voffB);
            PG8_WAIT_V(6); PG8_BAR; PG8_MMA(1, 1, At, B1); PG8_BAR;
            PG8_LDB(B0, 1, 0); PG8_SCHED; PG8_LDA(At, 1, 0); PG8_STAGE(PG8_SA(0, 1), a2 + hstep, voffA);
            PG8_WAIT_L(8); PG8_BAR; PG8_WAIT_L(0); PG8_MMA(0, 0, At, B0); PG8_BAR; PG8_SCHED;
            PG8_LDB(B1, 1, 1); PG8_STAGE(PG8_SB(1, 0), b3, voffB);
            PG8_BAR; PG8_WAIT_L(0); PG8_MMA(0, 1, At, B1); PG8_BAR;
            PG8_LDA(At, 1, 1); PG8_STAGE(PG8_SA(1, 0), a3, voffA);
            PG8_BAR; PG8_WAIT_L(0); PG8_MMA(1, 0, At, B0); PG8_BAR; PG8_SCHED;
            PG8_STAGE(PG8_SB(1, 1), b3 + hstep, voffB);
            PG8_WAIT_V(6); PG8_BAR; PG8_MMA(1, 1, At, B1); PG8_BAR;
            }
        }
        if constexpr (ALIGN_EPI) { if (wr == 0) PG8_BAR; }
        if constexpr (!Epi::AFTER_DRAIN) { E(acc, cur, wr, wc, fr, fq); S.done(cur); }
        if (!has_next) break;
#pragma unroll
        for (int a = 0; a < 2; ++a)
#pragma unroll
            for (int b = 0; b < 2; ++b)
#pragma unroll
                for (int m = 0; m < 4; ++m)
#pragma unroll
                    for (int n = 0; n < 2; ++n) acc[a][b][m][n] = (f32x4){0.f, 0.f, 0.f, 0.f};
        cur = nxt; cA = nA; cB = nB; ++ui;
        if constexpr (ALIGN_EPI) { if (wr == 1) PG8_BAR; }
    }
    PG8_WAIT_V(0);
    if constexpr (!ALIGN_EPI) { if (wr == 0) PG8_BAR; }
    PG8_BAR;
    if constexpr (Epi::AFTER_DRAIN) { E.fused(acc, cur, wr, wc, fr, fq, lds, wid, lane); S.done(cur); }
#undef PG8_SA
#undef PG8_SB
#undef PG8_STAGE
#undef PG8_LDA
#undef PG8_LDB
#undef PG8_MMA
#undef PG8_WAIT_V
#undef PG8_WAIT_L
#undef PG8_BAR
#undef PG8_SCHED
}
}

#ifndef MK_PER_PHASE
#define MK_PER_PHASE 0
#endif
constexpr int D = 1024, BATCH = 4, SEQ = 4096, M = BATCH * SEQ;
constexpr int POOLW = 512, QR = 384, KVR = 256, INW = 1184, INWP = 1280;
constexpr int NH = 8, QKD = 96, VD = 64, FF = 2816;
constexpr float ALPHA = 1.189207115002721f, LN_EPS = 1e-5f, RMS_EPS = 1e-6f;
constexpr float SCQ = 0.14724444602590306f;
constexpr size_t MiB = 1u << 20;
constexpr size_t WS_WIN = 1 * MiB, WS_WPOOL = 7 * MiB / 2, WS_WQ = 4 * MiB, WS_WKV = 5 * MiB, WS_WO = 6 * MiB, WS_WGU = 8 * MiB, WS_WD = 19 * MiB;
constexpr size_t WS_XB = 25 * MiB, WS_U = 57 * MiB, WS_CQ = 73 * MiB, WS_CKV = 85 * MiB, WS_KR = 93 * MiB, WS_CS = 94 * MiB, WS_RSTD = 96 * MiB, WS_PG = 97 * MiB;
constexpr size_t WS_CAT = 113 * MiB, WS_Q = 145 * MiB, WS_K = 169 * MiB, WS_VT = 193 * MiB;
constexpr size_t WS_Y1 = 25 * MiB;
constexpr size_t WS_X1B = 209 * MiB;
constexpr size_t WS_HB = 113 * MiB;
constexpr size_t WS_END = 256 * MiB;
static_assert(WS_WD + (size_t)D * FF * 2 <= WS_XB && WS_HB + (size_t)M * FF * 2 <= WS_X1B && WS_X1B + (size_t)M * D * 2 <= WS_END && WS_Y1 + (size_t)M * D * 4 <= WS_KR, "ws map");
constexpr int LDS_BYTES = 147456;
constexpr int NWAVES = 8;

#define LAS __attribute__((address_space(3)))
typedef unsigned short bf16;
typedef unsigned u32x4 __attribute__((ext_vector_type(4)));
typedef unsigned u32x2 __attribute__((ext_vector_type(2)));
typedef float f32x4 __attribute__((ext_vector_type(4)));
typedef float f32x16 __attribute__((ext_vector_type(16)));
typedef short bf16x8 __attribute__((ext_vector_type(8)));

typedef __attribute__((address_space(4))) const unsigned char* kptr_t;
template <class T> __device__ __forceinline__ T karg(int byte_off) { kptr_t p = (kptr_t)__builtin_amdgcn_kernarg_segment_ptr(); asm volatile("" : "+s"(p)); return *(__attribute__((address_space(4))) const T*)(p + byte_off); }
#define KIN(i) karg<const float*>(8 * (i))
#define KOUT() karg<float*>(144)
#define KWS() karg<unsigned char*>(152)
__device__ __forceinline__ unsigned pk2(float lo, float hi) { return pg8::cvt_pk_bf16(lo, hi); }
__device__ __forceinline__ u32x4 pack8(f32x4 a, f32x4 b) { u32x4 w; w.x = pk2(a[0], a[1]); w.y = pk2(a[2], a[3]); w.z = pk2(b[0], b[1]); w.w = pk2(b[2], b[3]); return w; }
__device__ __forceinline__ float bflo(unsigned w) { return __uint_as_float(w << 16); }
__device__ __forceinline__ float bfhi(unsigned w) { return __uint_as_float(w & 0xffff0000u); }
__device__ __forceinline__ float wave_sum(float v) {
#pragma unroll
    for (int o = 1; o < 64; o <<= 1) v += __shfl_xor(v, o);
    return v;
}

#define XB_TMO      128
#define XB_XCNT(j)  (256  + 64 * (j))
#define XB_XSUB(j)  (1280 + 64 * (j))
#define XB_XGEN(j)  (2304 + 64 * (j))
#define XB_TOP      3328
#define XB_TOPGEN   3392
#define XCD_BAR_WORDS 3456
#define XB_SPIN_CAP (1u << 18)

__device__ __forceinline__ unsigned xb_ld(unsigned* p)              { return __hip_atomic_load(p, __ATOMIC_RELAXED, __HIP_MEMORY_SCOPE_AGENT); }
__device__ __forceinline__ unsigned xb_add(unsigned* p, unsigned v) { return __hip_atomic_fetch_add(p, v, __ATOMIC_RELAXED, __HIP_MEMORY_SCOPE_AGENT); }
__device__ __forceinline__ unsigned xb_xcc_id() { return (unsigned)__builtin_amdgcn_s_getreg((3 << 11) | 20) & 0xFu; }
#define XB_SPIN(cond, bar) do { unsigned _sp = 0; while (cond) { __builtin_amdgcn_s_sleep(1); \
    if ((++_sp & 255u) == 0u) { if (xb_ld(&(bar)[XB_TMO])) break; if (_sp > XB_SPIN_CAP) { atomicAdd(&(bar)[XB_TMO], 1u); break; } } } } while (0)

struct XcdBarrier {
    unsigned* bar; unsigned x;
    volatile LAS unsigned* st;
};

__device__ __forceinline__ XcdBarrier xcd_barrier_post(unsigned* bar, volatile LAS unsigned* st, bool t0) {
    XcdBarrier b; b.bar = bar; b.x = xb_xcc_id(); b.st = st;
    if (t0) (void)xb_add(&bar[XB_XCNT(b.x)], 1u);
    return b;
}
__device__ __forceinline__ void xcd_barrier_complete(unsigned* bar, unsigned x, unsigned& nloc, unsigned& nx) {
    const unsigned G = gridDim.x * gridDim.y * gridDim.z;
    unsigned sum, cnt, mine, sp = 0u;
    for (;;) {
        sum = 0u; cnt = 0u; mine = 0u;
#pragma unroll
        for (unsigned j = 0; j < 16; ++j) { const unsigned c = xb_ld(&bar[XB_XCNT(j)]); sum += c; cnt += (c > 0u) ? 1u : 0u; mine = (j == x) ? c : mine; }
        if (sum == G) break;
        __builtin_amdgcn_s_sleep(1);
        if ((++sp & 255u) == 0u) { if (xb_ld(&bar[XB_TMO])) break; if (sp > XB_SPIN_CAP) { atomicAdd(&bar[XB_TMO], 1u); break; } }
    }
    nloc = mine > 0u ? mine : 1u; nx = cnt > 0u ? cnt : 1u;
}

__device__ __forceinline__ void xcd_barrier(const XcdBarrier& b, bool t0) {
    asm volatile("s_waitcnt vmcnt(0)" ::: "memory");
    __syncthreads();
    if (t0) {
        unsigned* bar = b.bar;
        __builtin_amdgcn_s_waitcnt(0);
        unsigned nloc = b.st[0], nx = b.st[1];
        if (nloc == 0u) { xcd_barrier_complete(bar, b.x, nloc, nx); b.st[0] = nloc; b.st[1] = nx; }
        const unsigned old = xb_add(&bar[XB_XSUB(b.x)], 1u);
        const unsigned gen = old / nloc;
        if (old + 1u == (gen + 1u) * nloc) {
            __builtin_amdgcn_fence(__ATOMIC_RELEASE, "agent");
            asm volatile("s_waitcnt vmcnt(0)" ::: "memory");
            const unsigned og = xb_add(&bar[XB_TOP], 1u);
            const unsigned tg = og / nx;
            if (og + 1u == (tg + 1u) * nx) xb_add(&bar[XB_TOPGEN], 1u);
            else XB_SPIN(xb_ld(&bar[XB_TOPGEN]) == tg, bar);
            __builtin_amdgcn_fence(__ATOMIC_ACQUIRE, "agent");
            xb_add(&bar[XB_XGEN(b.x)], 1u);
            asm volatile("s_waitcnt vmcnt(0)" ::: "memory");
        } else {
            XB_SPIN(xb_ld(&bar[XB_XGEN(b.x)]) == gen, bar);
            __builtin_amdgcn_fence(__ATOMIC_ACQUIRE, "agent");
            asm volatile("s_waitcnt vmcnt(0)" ::: "memory");
        }
    }
    __syncthreads();
}

using pg8::Unit;
struct EpiInProj {
    static constexpr bool PERM = true, AFTER_DRAIN = false; bf16 *U, *CQ, *CKV, *KR;
    __device__ __forceinline__ void operator()(const f32x4 (&acc)[2][2][4][2], const Unit& u, int wr_, int wc_, int fr_, int fq_) const {
        const int l_ = lane_id_v(), wr = wr_, wc = wc_, fr = l_ & 15, fq = l_ >> 4; (void)fr_; (void)fq_;
        const int row0 = u.pm * 256 + wr * 64 + fr;
#pragma unroll
        for (int bj = 0; bj < 2; ++bj) {
            const int c0 = u.pn * 256 + bj * 128 + wc * 32 + 8 * fq; bf16* base; int ld, cc;
            if (c0 < 512) { base = U; ld = 512; cc = c0; } else if (c0 < 896) { base = CQ; ld = 384; cc = c0 - 512; } else if (c0 < 1152) { base = CKV; ld = 256; cc = c0 - 896; }
            else if (c0 < 1184) { base = KR; ld = 32; cc = c0 - 1152; } else continue;
#pragma unroll
            for (int ai = 0; ai < 2; ++ai)
#pragma unroll
                for (int m = 0; m < 4; ++m) { const int row = row0 + ai * 128 + m * 16; *(u32x4*)(base + (size_t)row * ld + cc) = pack8(acc[ai][bj][m][0], acc[ai][bj][m][1]); }
        }
    }
};
struct EpiPlain {
    static constexpr bool PERM = true, AFTER_DRAIN = false; bf16* O; int ldc;
    __device__ __forceinline__ void operator()(const f32x4 (&acc)[2][2][4][2], const Unit& u, int wr_, int wc_, int fr_, int fq_) const {
        const int l_ = lane_id_v(), wr = wr_, wc = wc_, fr = l_ & 15, fq = l_ >> 4; (void)fr_; (void)fq_;
        const int row0 = u.pm * 256 + wr * 64 + fr;
#pragma unroll
        for (int bj = 0; bj < 2; ++bj) { const int c0 = u.pn * 256 + bj * 128 + wc * 32 + 8 * fq;
#pragma unroll
            for (int ai = 0; ai < 2; ++ai)
#pragma unroll
                for (int m = 0; m < 4; ++m) { const int row = row0 + ai * 128 + m * 16; *(u32x4*)(O + (size_t)row * ldc + c0) = pack8(acc[ai][bj][m][0], acc[ai][bj][m][1]); } }
    }
};
struct EpiQ {
    static constexpr bool PERM = true, AFTER_DRAIN = false; bf16* Q; const float* RSTD; const float* CS;
    __device__ __forceinline__ void operator()(const f32x4 (&acc)[2][2][4][2], const Unit& u, int wr_, int wc_, int fr_, int fq_) const {
        const int l_ = lane_id_v(), wr = wr_, wc = wc_, fr = l_ & 15, fq = l_ >> 4; (void)fr_; (void)fq_;
        const int row0 = u.pm * 256 + wr * 64 + fr;
#pragma unroll
        for (int ai = 0; ai < 2; ++ai)
#pragma unroll
            for (int m = 0; m < 4; ++m) { const int row = row0 + ai * 128 + m * 16; const float rs = RSTD[row * 2] * SCQ; const int b = row >> 12, s = row & 4095;
#pragma unroll
                for (int bj = 0; bj < 2; ++bj) { const int c0 = u.pn * 256 + bj * 128 + wc * 32 + 8 * fq; const int h = c0 / 96, d0 = c0 - h * 96;
                    f32x4 v0 = acc[ai][bj][m][0], v1 = acc[ai][bj][m][1];
                    if (d0 >= 64) { const int i = (d0 - 64) >> 1; const f32x4 c = *(const f32x4*)(CS + (size_t)row * 32 + i), sn = *(const f32x4*)(CS + (size_t)row * 32 + 16 + i);
                        f32x4 a, bb;
                        a[0] = v0[0] * c[0] - v0[1] * sn[0]; a[1] = v0[1] * c[0] + v0[0] * sn[0]; a[2] = v0[2] * c[1] - v0[3] * sn[1]; a[3] = v0[3] * c[1] + v0[2] * sn[1];
                        bb[0] = v1[0] * c[2] - v1[1] * sn[2]; bb[1] = v1[1] * c[2] + v1[0] * sn[2]; bb[2] = v1[2] * c[3] - v1[3] * sn[3]; bb[3] = v1[3] * c[3] + v1[2] * sn[3];
                        v0 = a; v1 = bb; }
                    v0 = v0 * rs; v1 = v1 * rs;
                    *(u32x4*)(Q + ((size_t)(b * NH + h) * SEQ + s) * QKD + d0) = pack8(v0, v1); }
                asm volatile("" ::: "memory"); }
    }
};
__device__ __forceinline__ int perm16(int k) { return (k & 3) | ((k & 4) << 1) | ((k & 8) >> 1); }
struct EpiKV {
    static constexpr bool PERM = true, AFTER_DRAIN = false; bf16 *K, *VT; const float* RSTD;
    __device__ __forceinline__ void operator()(const f32x4 (&acc)[2][2][4][2], const Unit& u, int wr_, int wc_, int fr_, int fq_) const {
        const int l_ = lane_id_v(), wr = wr_, wc = wc_, fr = l_ & 15, fq = l_ >> 4; (void)fr_; (void)fq_;
        const int row0 = u.pm * 256 + wr * 64 + fr;
#pragma unroll
        for (int ai = 0; ai < 2; ++ai)
#pragma unroll
            for (int m = 0; m < 4; ++m) { const int row = row0 + ai * 128 + m * 16; const float rs = RSTD[row * 2 + 1]; const int b = row >> 12, s = row & 4095;
#pragma unroll
                for (int bj = 0; bj < 2; ++bj) { const int c0 = u.pn * 256 + bj * 128 + wc * 32 + 8 * fq;
                    const u32x4 w = pack8(acc[ai][bj][m][0] * rs, acc[ai][bj][m][1] * rs);
                    if (c0 < 512) { const int h = c0 >> 6, d0 = c0 & 63; *(u32x4*)(K + ((size_t)(b * NH + h) * SEQ + s) * QKD + d0) = w; }
                    else { const int cc = c0 - 512, h = cc >> 6, dv0 = cc & 63; const int sp = (s & ~15) | perm16(s & 15);
                        bf16* p = VT + ((size_t)(b * NH + h) * VD + dv0) * SEQ + sp;
                        p[0 * SEQ] = (bf16)(w.x & 0xffffu); p[1 * SEQ] = (bf16)(w.x >> 16); p[2 * SEQ] = (bf16)(w.y & 0xffffu); p[3 * SEQ] = (bf16)(w.y >> 16);
                        p[4 * SEQ] = (bf16)(w.z & 0xffffu); p[5 * SEQ] = (bf16)(w.z >> 16); p[6 * SEQ] = (bf16)(w.w & 0xffffu); p[7 * SEQ] = (bf16)(w.w >> 16); }
                    asm volatile("" ::: "memory"); } }
    }
};
struct EpiResid {
    static constexpr bool PERM = true, AFTER_DRAIN = false; const float* R; float* Y;
    __device__ __forceinline__ void operator()(const f32x4 (&acc)[2][2][4][2], const Unit& u, int wr_, int wc_, int fr_, int fq_) const {
        const int l_ = lane_id_v(), wr = wr_, wc = wc_, fr = l_ & 15, fq = l_ >> 4; (void)fr_; (void)fq_;
        const int row0 = u.pm * 256 + wr * 64 + fr;
#pragma unroll
        for (int ai = 0; ai < 2; ++ai)
#pragma unroll
            for (int m = 0; m < 4; ++m) { const int row = row0 + ai * 128 + m * 16;
#pragma unroll
                for (int bj = 0; bj < 2; ++bj) { const size_t off = (size_t)row * D + u.pn * 256 + bj * 128 + wc * 32 + 8 * fq;
                    const f32x4 r0 = *(const f32x4*)(R + off), r1 = *(const f32x4*)(R + off + 4);
                    *(f32x4*)(Y + off) = r0 * ALPHA + acc[ai][bj][m][0]; *(f32x4*)(Y + off + 4) = r1 * ALPHA + acc[ai][bj][m][1]; } }
    }
};
__device__ __forceinline__ float silu_mul(float g, float up) { return g * __builtin_amdgcn_rcpf(1.f + __builtin_amdgcn_exp2f(-1.4426950408889634f * g)) * up; }
struct EpiSwiGLU {
    static constexpr bool PERM = true, AFTER_DRAIN = false; bf16* HB;
    __device__ __forceinline__ void operator()(const f32x4 (&acc)[2][2][4][2], const Unit& u, int wr_, int wc_, int fr_, int fq_) const {
        const int l_ = lane_id_v(), wr = wr_, wc = wc_, fr = l_ & 15, fq = l_ >> 4; (void)fr_; (void)fq_;
        const int row0 = u.pm * 256 + wr * 64 + fr, c0 = u.pn * 128 + wc * 32 + 8 * fq;
#pragma unroll
        for (int ai = 0; ai < 2; ++ai)
#pragma unroll
            for (int m = 0; m < 4; ++m) { const int row = row0 + ai * 128 + m * 16; f32x4 h0, h1;
#pragma unroll
                for (int e = 0; e < 4; ++e) { h0[e] = silu_mul(acc[ai][0][m][0][e], acc[ai][1][m][0][e]); h1[e] = silu_mul(acc[ai][0][m][1][e], acc[ai][1][m][1][e]); }
                *(u32x4*)(HB + (size_t)row * FF + c0) = pack8(h0, h1); }
    }
};

#define LAUNDER_TID() const int lane = lane_id_v(), t_l = wave * 64 + lane
__device__ __forceinline__ void p0_prologue(LAS unsigned char* lds, int wave) {
    LAUNDER_TID();
    LAS float* scr = (LAS float*)(lds + wave * 16384);
    const int gw = blockIdx.x * NWAVES + wave, NGW = gridDim.x * NWAVES;
    unsigned char* ws = KWS();
    bf16 *WinT = (bf16*)(ws + WS_WIN), *WpoolT = (bf16*)(ws + WS_WPOOL), *WqT = (bf16*)(ws + WS_WQ), *WkvT = (bf16*)(ws + WS_WKV), *WoT = (bf16*)(ws + WS_WO), *WguT = (bf16*)(ws + WS_WGU), *WdT = (bf16*)(ws + WS_WD);
    constexpr int I_IN = 16 * 40, I_POOL = 8 * 16, I_Q = 6 * 24, I_KV = 4 * 32, I_O = 16 * 32, I_GU = 16 * 176, I_D = 44 * 32;
    constexpr int NITEMS = I_IN + I_POOL + I_Q + I_KV + I_O + I_GU + I_D;
    for (int it = gw; it < NITEMS; it += NGW) {
        int r = it; const float* Wp; int ldw; const float* ksc = nullptr; int ksrc0, kdst0, n0; bf16* WT; int ldt; bool zero = false; const int nl = lane & 31; int col; float nsc = 1.f;
        if (r < I_IN) { const int kb = r / 40, nb = r % 40; Wp = KIN(2); ldw = INW; ksrc0 = kdst0 = 64 * kb; n0 = 32 * nb; WT = WinT; ldt = D; col = n0 + nl; zero = n0 >= INW; }
        else if ((r -= I_IN) < I_POOL) { const int kb = r / 16, nb = r % 16, gk = kb >> 1, gn = nb >> 2; Wp = KIN(3) + gk * 16384; ldw = 128; ksrc0 = (64 * kb) & 127; kdst0 = 64 * kb; n0 = 32 * nb; WT = WpoolT; ldt = 512;
            col = (n0 + nl) & 127; nsc = KIN(4)[n0 + nl]; zero = gk != gn; }
        else if ((r -= I_POOL) < I_Q) { const int kb = r / 24, nb = r % 24; Wp = KIN(6); ldw = 768; ksc = KIN(5); ksrc0 = kdst0 = 64 * kb; n0 = 32 * nb; WT = WqT; ldt = QR;
            const int n = n0 + nl, h = n / 96, d = n - h * 96; col = n; if (d >= 64) { const int j = d - 64, i = j >> 1; col = h * 96 + 64 + ((j & 1) ? 16 + i : i); } }
        else if ((r -= I_Q) < I_KV) { const int kb = r / 32, nb = r % 32; n0 = 32 * nb; Wp = n0 < 512 ? KIN(8) : KIN(9); ldw = 512; ksc = KIN(7); ksrc0 = kdst0 = 64 * kb; WT = WkvT; ldt = KVR; col = (n0 + nl) & 511; }
        else if ((r -= I_KV) < I_O) { const int kb = r / 32, nb = r % 32; Wp = KIN(10); ldw = D; ksrc0 = kdst0 = 64 * kb; n0 = 32 * nb; WT = WoT; ldt = D; col = n0 + nl; }
        else if ((r -= I_O) < I_GU) { const int kb = r / 176, nb = r % 176; n0 = 32 * nb; const int pn = n0 >> 8, w = n0 & 255; Wp = w < 128 ? KIN(13) : KIN(14); ldw = FF; ksrc0 = kdst0 = 64 * kb; WT = WguT; ldt = D; col = pn * 128 + (w & 127) + nl; }
        else { r -= I_GU; const int kb = r / 32, nb = r % 32; Wp = KIN(15); ldw = D; ksrc0 = kdst0 = 64 * kb; n0 = 32 * nb; WT = WdT; ldt = FF; col = n0 + nl; }
        float tv[32];
        const float* wl = Wp + (size_t)(ksrc0 + (lane >> 5)) * ldw + col;
#pragma unroll
        for (int i = 0; i < 32; ++i) tv[i] = zero ? 0.f : wl[(size_t)(2 * i) * ldw];
        if (ksc) {
#pragma unroll
            for (int i = 0; i < 32; ++i) tv[i] *= ksc[ksrc0 + 2 * i + (lane >> 5)];
        }
#pragma unroll
        for (int i = 0; i < 32; ++i) scr[(2 * i + (lane >> 5)) * 33 + nl] = tv[i] * nsc;
        asm volatile("s_waitcnt lgkmcnt(0)" ::: "memory");
        const int c = lane & 7;
#pragma unroll
        for (int j = 0; j < 4; ++j) { const int n = (lane >> 3) + 8 * j; const LAS float* sp = scr + (8 * c) * 33 + n;
            u32x4 o; o.x = pk2(sp[0 * 33], sp[1 * 33]); o.y = pk2(sp[2 * 33], sp[3 * 33]); o.z = pk2(sp[4 * 33], sp[5 * 33]); o.w = pk2(sp[6 * 33], sp[7 * 33]);
            *(u32x4*)(WT + (size_t)(n0 + n) * ldt + kdst0 + 8 * c) = o; }
        asm volatile("s_waitcnt lgkmcnt(0)" ::: "memory");
    }
    bf16* XB = (bf16*)(ws + WS_XB);
    const int gt = blockIdx.x * 512 + t_l, NT = gridDim.x * 512;
    const float* xin = KIN(0);
#pragma unroll 4
    for (int c = gt; c < M * D / 8; c += NT) { const f32x4 a = *(const f32x4*)(xin + (size_t)c * 8), b = *(const f32x4*)(xin + (size_t)c * 8 + 4); *(u32x4*)(XB + (size_t)c * 8) = pack8(a, b); }
}

__device__ __forceinline__ void unpack_add(float (&a)[8], u32x4 w) { a[0] += bflo(w.x); a[1] += bfhi(w.x); a[2] += bflo(w.y); a[3] += bfhi(w.y); a[4] += bflo(w.z); a[5] += bfhi(w.z); a[6] += bflo(w.w); a[7] += bfhi(w.w); }
__device__ __forceinline__ float sumsq8(u32x4 w) { float s = 0.f; float v;
    v = bflo(w.x); s += v * v; v = bfhi(w.x); s += v * v; v = bflo(w.y); s += v * v; v = bfhi(w.y); s += v * v; v = bflo(w.z); s += v * v; v = bfhi(w.z); s += v * v; v = bflo(w.w); s += v * v; v = bfhi(w.w); s += v * v; return s; }
__device__ __forceinline__ void rope_cs(int pos, int i, float& c, float& s) {
    const double f = i == 0 ? 1.0 : i == 1 ? 0.5623413251903491 : i == 2 ? 0.31622776601683794 : i == 3 ? 0.1778279410038923 : i == 4 ? 0.1 : i == 5 ? 0.05623413251903491 : i == 6 ? 0.03162277660168379 : i == 7 ? 0.01778279410038923
                   : i == 8 ? 0.01 : i == 9 ? 0.005623413251903491 : i == 10 ? 0.0031622776601683794 : i == 11 ? 0.0017782794100389228 : i == 12 ? 0.001 : i == 13 ? 0.0005623413251903491 : i == 14 ? 0.00031622776601683794 : 0.00017782794100389227;
    const double t = (double)pos * f * 0.15915494309189535;
    const float rev = (float)(t - rint(t));
    c = __builtin_amdgcn_cosf(rev); s = __builtin_amdgcn_sinf(rev);
}
__device__ __forceinline__ void p2_tokens(int wave) {
    LAUNDER_TID(); (void)t_l;
    unsigned char* ws = KWS(); const int* posp = karg<const int*>(8);
    const bf16 *U = (const bf16*)(ws + WS_U), *CQ = (const bf16*)(ws + WS_CQ), *CKV = (const bf16*)(ws + WS_CKV), *KR = (const bf16*)(ws + WS_KR);
    bf16 *PG = (bf16*)(ws + WS_PG), *K = (bf16*)(ws + WS_K); float *CS = (float*)(ws + WS_CS), *RSTD = (float*)(ws + WS_RSTD);
    const int gw = blockIdx.x * NWAVES + wave, NGW = gridDim.x * NWAVES;
    for (int m = gw; m < M; m += NGW) {
        const int s = m & (SEQ - 1), b0 = m - s, b = m >> 12;
        const int g = lane >> 4, w = 2 << g, hw = w >> 1;
        u32x4 wv[16];
#pragma unroll
        for (int jj = 0; jj < 16; ++jj) { const int j = s - hw + jj; const bool ok = (jj < w) && (j >= 0) && (j < SEQ); wv[jj] = *(const u32x4*)(U + (size_t)(b0 + (ok ? j : s)) * POOLW + lane * 8); }
        const u32x4 selfw = *(const u32x4*)(U + (size_t)m * POOLW + lane * 8);
        const u32x4 cqw = *(const u32x4*)(CQ + (size_t)m * QR + (lane < 48 ? lane : 47) * 8);
        const u32x4 ckw = *(const u32x4*)(CKV + (size_t)m * KVR + (lane & 31) * 8);
        const int hd = lane >> 3, ii = lane & 7, i0 = 2 * ii, i1 = i0 + 1; const int pos = posp[m];
        const unsigned w1 = *(const unsigned*)(KR + (size_t)m * 32 + i0), w2 = *(const unsigned*)(KR + (size_t)m * 32 + 16 + i0);
        { int lo = s - hw; if (lo < 0) lo = 0; int hi = s + w - hw; if (hi > SEQ) hi = SEQ;
          float a[8] = {0.f, 0.f, 0.f, 0.f, 0.f, 0.f, 0.f, 0.f};
#pragma unroll
          for (int jj = 0; jj < 16; ++jj) { const int j = s - hw + jj; const bool ok = (jj < w) && (j >= 0) && (j < SEQ); u32x4 t = wv[jj]; if (!ok) t = (u32x4){0u, 0u, 0u, 0u}; unpack_add(a, t); }
          float sf[8] = {0.f, 0.f, 0.f, 0.f, 0.f, 0.f, 0.f, 0.f}; unpack_add(sf, selfw);
          const float inv = 1.f / (float)(hi - lo);
          u32x4 o; o.x = pk2(a[0] * inv - sf[0], a[1] * inv - sf[1]); o.y = pk2(a[2] * inv - sf[2], a[3] * inv - sf[3]); o.z = pk2(a[4] * inv - sf[4], a[5] * inv - sf[5]); o.w = pk2(a[6] * inv - sf[6], a[7] * inv - sf[7]);
          *(u32x4*)(PG + (size_t)m * POOLW + lane * 8) = o; }
        { float sq = lane < 48 ? sumsq8(cqw) : 0.f, sk = lane < 32 ? sumsq8(ckw) : 0.f;
          sq = wave_sum(sq); sk = wave_sum(sk);
          if (lane == 0) { RSTD[m * 2] = 1.f / sqrtf(sq * (1.f / QR) + RMS_EPS); RSTD[m * 2 + 1] = 1.f / sqrtf(sk * (1.f / KVR) + RMS_EPS); } }
        { float c0, s0, c1, s1; rope_cs(pos, i0, c0, s0); rope_cs(pos, i1, c1, s1);
          const float t1a = bflo(w1), t1b = bfhi(w1), t2a = bflo(w2), t2b = bfhi(w2);
          u32x2 o; o.x = pk2(t1a * c0 - t2a * s0, t2a * c0 + t1a * s0); o.y = pk2(t1b * c1 - t2b * s1, t2b * c1 + t1b * s1);
          *(u32x2*)(K + ((size_t)(b * NH + hd) * SEQ + s) * QKD + 64 + 4 * ii) = o;
          if (hd == 0) { float* cs = CS + (size_t)m * 32; cs[i0] = c0; cs[i1] = c1; cs[16 + i0] = s0; cs[16 + i1] = s1; } }
    }
}

template <bool WB> __device__ __forceinline__ void ln_phase(const float* Y, float* O, bf16* OB, const float* g, const float* bta, int wave) {
    LAUNDER_TID(); (void)t_l;
    const int gw = blockIdx.x * NWAVES + wave, NGW = gridDim.x * NWAVES;
    f32x4 gv[4], bv[4];
#pragma unroll
    for (int j = 0; j < 4; ++j) { gv[j] = *((const f32x4*)g + lane + 64 * j); bv[j] = *((const f32x4*)bta + lane + 64 * j); }
#pragma unroll 2
    for (int m = gw; m < M; m += NGW) {
        const f32x4* yr = (const f32x4*)(Y + (size_t)m * D) + lane; f32x4 v[4]; float s = 0.f;
#pragma unroll
        for (int j = 0; j < 4; ++j) { v[j] = yr[64 * j]; s += (v[j].x + v[j].y) + (v[j].z + v[j].w); }
        const float mean = wave_sum(s) * (1.f / D); float s2 = 0.f;
#pragma unroll
        for (int j = 0; j < 4; ++j) { v[j] = v[j] - mean; s2 += (v[j].x * v[j].x + v[j].y * v[j].y) + (v[j].z * v[j].z + v[j].w * v[j].w); }
        const float rstd = 1.f / sqrtf(wave_sum(s2) * (1.f / D) + LN_EPS);
#pragma unroll
        for (int j = 0; j < 4; ++j) { const f32x4 o = v[j] * rstd * gv[j] + bv[j]; *((f32x4*)(O + (size_t)m * D) + lane + 64 * j) = o;
            if (WB) { u32x2 w; w.x = pk2(o.x, o.y); w.y = pk2(o.z, o.w); *((u32x2*)(OB + (size_t)m * D) + lane + 64 * j) = w; } }
    }
}

namespace att {
constexpr int KROW = 208, VROW = 144, KT_BYTES = 64 * KROW, VT_BYTES = 64 * VROW, BUF = KT_BYTES + VT_BYTES;
__device__ __forceinline__ bf16x8 pk8(const f32x16& p, int o) {
    u32x4 w; w.x = pk2(p[o + 0], p[o + 1]); w.y = pk2(p[o + 2], p[o + 3]); w.z = pk2(p[o + 4], p[o + 5]); w.w = pk2(p[o + 6], p[o + 7]); return __builtin_bit_cast(bf16x8, w); }
__device__ __forceinline__ void attn_unit(LAS unsigned char* lds, const bf16* Qg, const bf16* Kg, const bf16* VTg, bf16* CAT, int b, int h, int qb, int wave) {
    const int lane = lane_id_v(), wid = wave, tid = wid * 64 + lane, r = lane & 31, hh = lane >> 5;
    const bf16* Qh = Qg + ((size_t)(b * NH + h) * SEQ + qb * 256 + wid * 32) * QKD;
    const bf16* Kh = Kg + (size_t)(b * NH + h) * SEQ * QKD;
    const bf16* Vh = VTg + (size_t)(b * NH + h) * VD * SEQ;
    bf16x8 qf[6];
#pragma unroll
    for (int ks = 0; ks < 6; ++ks) qf[ks] = *(const bf16x8*)(Qh + r * QKD + ks * 16 + hh * 8);
    const int kc1 = 512 + tid;
    const int koff0 = (tid / 12) * KROW + (tid % 12) * 16, koff1 = (kc1 / 12) * KROW + (kc1 % 12) * 16, voff = KT_BYTES + (tid >> 3) * VROW + (tid & 7) * 16;
    const bf16* kg0 = Kh + tid * 8; const bf16* kg1 = Kh + kc1 * 8; const bf16* vg = Vh + (size_t)(tid >> 3) * SEQ + (tid & 7) * 8;
    u32x4 kr0, kr1 = {0u, 0u, 0u, 0u}, vr;
    kr0 = *(const u32x4*)kg0; if (tid < 256) kr1 = *(const u32x4*)kg1; vr = *(const u32x4*)vg;
    *(LAS u32x4*)(lds + koff0) = kr0; if (tid < 256) *(LAS u32x4*)(lds + koff1) = kr1; *(LAS u32x4*)(lds + voff) = vr;
    __syncthreads();
    float mrow = -1e30f, lsum = 0.f; f32x16 o0 = {}, o1 = {};
    const int kread = r * KROW + hh * 16, vread = KT_BYTES + r * VROW + hh * 16;
    for (int t = 0; t < SEQ / 64; ++t) {
        const bool more = (t + 1 < SEQ / 64);
        if (more) { kr0 = *(const u32x4*)(kg0 + (size_t)(t + 1) * 64 * QKD); if (tid < 256) kr1 = *(const u32x4*)(kg1 + (size_t)(t + 1) * 64 * QKD); vr = *(const u32x4*)(vg + (t + 1) * 64); }
        LAS unsigned char* cur = lds + (t & 1) * BUF;
        f32x16 p0 = {}, p1 = {};
#pragma unroll
        for (int ks = 0; ks < 6; ++ks) {
            const bf16x8 a0 = *(const LAS bf16x8*)(cur + kread + ks * 32), a1 = *(const LAS bf16x8*)(cur + kread + 32 * KROW + ks * 32);
            p0 = __builtin_amdgcn_mfma_f32_32x32x16_bf16(a0, qf[ks], p0, 0, 0, 0); p1 = __builtin_amdgcn_mfma_f32_32x32x16_bf16(a1, qf[ks], p1, 0, 0, 0);
        }
        float tmax = fmaxf(p0[0], p1[0]);
#pragma unroll
        for (int e = 1; e < 16; ++e) tmax = fmaxf(tmax, fmaxf(p0[e], p1[e]));
        tmax = fmaxf(tmax, __shfl_xor(tmax, 32));
        const float mnew = fmaxf(mrow, tmax), alpha = __builtin_amdgcn_exp2f(mrow - mnew); mrow = mnew;
        float ps = 0.f;
#pragma unroll
        for (int e = 0; e < 16; ++e) { p0[e] = __builtin_amdgcn_exp2f(p0[e] - mnew); p1[e] = __builtin_amdgcn_exp2f(p1[e] - mnew); ps += p0[e] + p1[e]; }
        lsum = lsum * alpha + ps;
#pragma unroll
        for (int e = 0; e < 16; ++e) { o0[e] *= alpha; o1[e] *= alpha; }
        bf16x8 pf[4]; pf[0] = pk8(p0, 0); pf[1] = pk8(p0, 8); pf[2] = pk8(p1, 0); pf[3] = pk8(p1, 8);
#pragma unroll
        for (int ks = 0; ks < 4; ++ks) {
            const bf16x8 v0 = *(const LAS bf16x8*)(cur + vread + ks * 32), v1 = *(const LAS bf16x8*)(cur + vread + 32 * VROW + ks * 32);
            o0 = __builtin_amdgcn_mfma_f32_32x32x16_bf16(v0, pf[ks], o0, 0, 0, 0); o1 = __builtin_amdgcn_mfma_f32_32x32x16_bf16(v1, pf[ks], o1, 0, 0, 0);
        }
        if (more) { LAS unsigned char* nxt = lds + ((t + 1) & 1) * BUF; *(LAS u32x4*)(nxt + koff0) = kr0; if (tid < 256) *(LAS u32x4*)(nxt + koff1) = kr1; *(LAS u32x4*)(nxt + voff) = vr; }
        __syncthreads();
    }
    const float inv = 1.f / (lsum + __shfl_xor(lsum, 32));
    bf16* orow = CAT + (size_t)(b * SEQ + qb * 256 + wid * 32 + r) * D + 512 + h * VD + 4 * hh;
#pragma unroll
    for (int g = 0; g < 4; ++g) {
        u32x2 w; w.x = pk2(o0[4 * g] * inv, o0[4 * g + 1] * inv); w.y = pk2(o0[4 * g + 2] * inv, o0[4 * g + 3] * inv); *(u32x2*)(orow + 8 * g) = w;
        u32x2 w2; w2.x = pk2(o1[4 * g] * inv, o1[4 * g + 1] * inv); w2.y = pk2(o1[4 * g + 2] * inv, o1[4 * g + 3] * inv); *(u32x2*)(orow + 32 + 8 * g) = w2;
    }
}
}

struct Args { const void* in[18]; float* out; unsigned char* ws; int ph_lo, ph_hi; };
constexpr int N_PHASES = 10;
__global__ void __launch_bounds__(NWAVES * 64, 2) mega_fwd(Args args) {
    extern __shared__ __attribute__((aligned(16))) unsigned char lds_raw[];
    LAS unsigned char* lds = (LAS unsigned char*)lds_raw;
    cg::grid_group grid = cg::this_grid();
    const int wave = __builtin_amdgcn_readfirstlane(threadIdx.x >> 6);
    const int G = gridDim.x, cu = blockIdx.x;
    volatile LAS unsigned* MISC = (volatile LAS unsigned*)(lds + 131072);
    if (threadIdx.x < 64) MISC[threadIdx.x] = 0u;
    __syncthreads();
    (void)xcd_barrier_post((unsigned*)KWS() + 1024, MISC + 8, threadIdx.x == 0);
    const int lo = karg<int>(160), hi = karg<int>(164); (void)args;
#ifndef MK_MASK
#define MK_MASK 0x3ff
#endif
#define WSP(T, off) ((T*)(KWS() + (off)))
#define IN(k) (((MK_MASK >> (k)) & 1) && lo <= (k) && (k) < hi)
#ifndef MK_REP
#define MK_REP 0
#endif
#define REP(k) (((MK_REP >> (k)) & 1) + 1)
#define SEAM(k) do { if (IN(k) && IN((k) + 1)) { if ((k) == 0) grid.sync(); else { XcdBarrier bar_; bar_.bar = (unsigned*)KWS() + 1024; bar_.x = xb_xcc_id(); bar_.st = MISC + 8; xcd_barrier(bar_, wave == 0 && lane_id_v() == 0); } } } while (0)
    typedef pg8::StaticOrder SO;
    if (IN(0)) { p0_prologue(lds, wave); } SEAM(0);
    if (IN(1)) for (int rep_ = 0; rep_ < REP(1); ++rep_) { pg8::Gemm g{WSP(bf16, WS_XB), WSP(bf16, WS_WIN), M, INWP, D}; SO S; S.init(M, INWP, G, cu); EpiInProj E{WSP(bf16, WS_U), WSP(bf16, WS_CQ), WSP(bf16, WS_CKV), WSP(bf16, WS_KR)};
        pg8::gemm_phase<EpiInProj, SO, true, true>(lds, g, S, E, wave); } SEAM(1);
    if (IN(2)) { p2_tokens(wave); } SEAM(2);
    if (IN(3)) for (int rep_ = 0; rep_ < REP(3); ++rep_) {
        { pg8::Gemm g{WSP(bf16, WS_PG), WSP(bf16, WS_WPOOL), M, POOLW, POOLW}; SO S; S.init(M, POOLW, G, cu); EpiPlain E{WSP(bf16, WS_CAT), D}; pg8::gemm_phase<EpiPlain, SO, true, true>(lds, g, S, E, wave); }
        { pg8::Gemm g{WSP(bf16, WS_CQ), WSP(bf16, WS_WQ), M, NH * QKD, QR}; SO S; S.init(M, NH * QKD, G, (cu + 128) % G); EpiQ E{WSP(bf16, WS_Q), WSP(float, WS_RSTD), WSP(float, WS_CS)}; pg8::gemm_phase<EpiQ, SO, true, true>(lds, g, S, E, wave); }
        { pg8::Gemm g{WSP(bf16, WS_CKV), WSP(bf16, WS_WKV), M, 1024, KVR}; SO S; S.init(M, 1024, G, cu); EpiKV E{WSP(bf16, WS_K), WSP(bf16, WS_VT), WSP(float, WS_RSTD)}; pg8::gemm_phase<EpiKV, SO, true, true>(lds, g, S, E, wave); }
    } SEAM(3);
    if (IN(4)) for (int rep_ = 0; rep_ < REP(4); ++rep_) {
        const int xcd = cu & 7, slot = cu >> 3;
        for (int uidx = slot; uidx < 64; uidx += (G >> 3)) { const int bh = xcd * 4 + (uidx >> 4), qb = uidx & 15;
            att::attn_unit(lds, WSP(bf16, WS_Q), WSP(bf16, WS_K), WSP(bf16, WS_VT), WSP(bf16, WS_CAT), bh >> 3, bh & 7, qb, wave); }
    } SEAM(4);
    if (IN(5)) for (int rep_ = 0; rep_ < REP(5); ++rep_) { pg8::Gemm g{WSP(bf16, WS_CAT), WSP(bf16, WS_WO), M, D, D}; SO S; S.init(M, D, G, cu); EpiResid E{KIN(0), WSP(float, WS_Y1)}; pg8::gemm_phase<EpiResid, SO, true, true>(lds, g, S, E, wave); } SEAM(5);
    if (IN(6)) { ln_phase<true>(WSP(float, WS_Y1), WSP(float, WS_Y1), WSP(bf16, WS_X1B), KIN(11), KIN(12), wave); } SEAM(6);
    if (IN(7)) for (int rep_ = 0; rep_ < REP(7); ++rep_) { pg8::Gemm g{WSP(bf16, WS_X1B), WSP(bf16, WS_WGU), M, 2 * FF, D}; SO S; S.init(M, 2 * FF, G, cu); EpiSwiGLU E{WSP(bf16, WS_HB)}; pg8::gemm_phase<EpiSwiGLU, SO, true, true>(lds, g, S, E, wave); } SEAM(7);
    if (IN(8)) for (int rep_ = 0; rep_ < REP(8); ++rep_) { pg8::Gemm g{WSP(bf16, WS_HB), WSP(bf16, WS_WD), M, D, FF}; SO S; S.init(M, D, G, cu); EpiResid E{WSP(float, WS_Y1), KOUT()}; pg8::gemm_phase<EpiResid, SO, true, true>(lds, g, S, E, wave); } SEAM(8);
    if (IN(9)) { ln_phase<false>(KOUT(), KOUT(), nullptr, KIN(16), KIN(17), wave); }
#undef IN
#undef SEAM
}

extern "C" void kernel_launch(void* const* d_in, const int* in_sizes, int n_in, void* d_out, int out_size, void* d_ws, size_t ws_size, hipStream_t stream) {
    static int grid = 0;
    if (grid == 0) {
        if (n_in != 18 || in_sizes[0] != M * D || out_size != M * D || ws_size < WS_END) { fprintf(stderr, "kernel_launch: unexpected shapes (n_in %d, ws %zu)\n", n_in, ws_size); grid = -1; return; }
        int dev = 0, cus = 0, per_cu = 0;
        hipGetDevice(&dev); hipDeviceGetAttribute(&cus, hipDeviceAttributeMultiprocessorCount, dev);
        if (hipFuncSetAttribute((const void*)mega_fwd, hipFuncAttributeMaxDynamicSharedMemorySize, LDS_BYTES) != hipSuccess) { fprintf(stderr, "kernel_launch: hipFuncSetAttribute failed\n"); grid = -1; return; }
        if (hipOccupancyMaxActiveBlocksPerMultiprocessor(&per_cu, (const void*)mega_fwd, NWAVES * 64, LDS_BYTES) != hipSuccess || per_cu < 1) { fprintf(stderr, "kernel_launch: occupancy query says %d blocks per CU\n", per_cu); grid = -1; return; }
        grid = cus;
        if (grid > 256) grid = 256;
    }
    if (grid < 0) return;
    if (hipMemsetAsync(d_ws, 0, 65536, stream) != hipSuccess) { fprintf(stderr, "kernel_launch: memset failed\n"); return; }
    Args a{};
    for (int i = 0; i < 18; ++i) a.in[i] = d_in[i];
    a.out = (float*)d_out; a.ws = (unsigned char*)d_ws;
#if MK_PER_PHASE
    for (int p = 0; p < N_PHASES; ++p) { a.ph_lo = p; a.ph_hi = p + 1; void* kargs[] = {&a};
        hipError_t e = hipLaunchCooperativeKernel((const void*)mega_fwd, dim3(grid), dim3(NWAVES * 64), kargs, LDS_BYTES, stream);
        if (e != hipSuccess) { fprintf(stderr, "kernel_launch: cooperative launch (phase %d) failed: %s\n", p, hipGetErrorString(e)); break; } }
#else
    a.ph_lo = 0; a.ph_hi = N_PHASES; void* kargs[] = {&a};
    hipError_t e = hipLaunchCooperativeKernel((const void*)mega_fwd, dim3(grid), dim3(NWAVES * 64), kargs, LDS_BYTES, stream);
    if (e != hipSuccess) fprintf(stderr, "kernel_launch: cooperative launch failed: %s (grid %d)\n", hipGetErrorString(e), grid);
#endif
}
```
